# Optimizing an MI355X kernel written in HIP

```python
import jax, jax.numpy as jnp
from jax import lax
import numpy as np

D_MODEL = 1024
BATCH = 16
SEQ = 256
DEPTH = 4
DEC_BATCH = 4
DEC_SEQ = 4096
PAST_LEN = 512

GRID_W = 64
Q_BLOCK = 128
A_HEADS = 8
A_KV_HEADS = 2
A_HEAD_DIM = 64
A_GROUP = A_HEADS // A_KV_HEADS
A_WINDOW = 128
B_HEADS = 8
B_Q_LORA = 384
B_KV_LORA = 256
B_NOPE = 64
B_ROPE = 32
B_QK_DIM = B_NOPE + B_ROPE
B_V_DIM = 64
C_WIDTH = 512
C_BLOCKS = 8
C_BLOCK_W = C_WIDTH // C_BLOCKS
C_CONV = 4
C_RG = 8.0
MIX_W = 512
N_BRANCH = 3
D_FF = 4 * D_MODEL
N_ADA = 6
ROPE_BASE = 10000.0
EPS = 1e-6
NEG_INF = -1e30
IN_SPLITS = (A_HEADS * A_HEAD_DIM, A_KV_HEADS * A_HEAD_DIM, A_KV_HEADS * A_HEAD_DIM,
             B_Q_LORA, B_KV_LORA, B_ROPE, C_WIDTH, C_WIDTH, N_BRANCH * D_MODEL)
IN_COLS = sum(IN_SPLITS)

kernel_name = 'hybrid_prefix_diffusion_step'

F32 = jnp.float32


def rms_norm(x, g):
    xf = x.astype(F32)
    y = xf * lax.rsqrt(jnp.mean(xf * xf, axis=-1, keepdims=True) + EPS)
    return (y * g.astype(F32)).astype(x.dtype)


def split_cols(proj):
    outs = []
    off = 0
    for n in IN_SPLITS:
        outs.append(proj[..., off:off + n])
        off += n
    return outs


def ada(cvec, lp):
    mod = jax.nn.silu(cvec) @ lp['w_ada'] + lp['b_ada']
    return jnp.split(mod, N_ADA, axis=-1)


def rope_1d(x, pos):
    m = x.shape[-1]
    half = m // 2
    inv = jnp.power(ROPE_BASE, -jnp.arange(half, dtype=F32) * (2.0 / m))
    ang = pos.astype(F32)[:, None] * inv
    cos = jnp.cos(ang)[:, None, :]
    sin = jnp.sin(ang)[:, None, :]
    xf = x.astype(F32)
    x1, x2 = xf[..., :half], xf[..., half:]
    return jnp.concatenate([x1 * cos - x2 * sin, x2 * cos + x1 * sin], axis=-1).astype(x.dtype)


def axial_rope(x, rows, cols):
    half = x.shape[-1] // 2
    return jnp.concatenate([rope_1d(x[..., :half], rows), rope_1d(x[..., half:], cols)], axis=-1)


def map_query_blocks(fn, q):
    b, t = q.shape[0], q.shape[1]
    nb = t // Q_BLOCK
    qb = jnp.moveaxis(q.reshape((b, nb, Q_BLOCK) + q.shape[2:]), 1, 0)
    out = lax.map(fn, (jnp.arange(nb), qb))
    out = jnp.moveaxis(out, 0, 1)
    return out.reshape((b, t) + out.shape[3:])


def sink_softmax_av(s, sink, v):
    sk = sink.astype(F32).reshape(1, A_KV_HEADS, A_GROUP, 1, 1)
    m = jnp.maximum(jnp.max(s, axis=-1, keepdims=True), sk)
    p = jnp.exp(s - m)
    p = p / (jnp.sum(p, axis=-1, keepdims=True) + jnp.exp(sk - m))
    o = jnp.einsum('bkgqs,bskd->bqkgd', p.astype(v.dtype), v)
    return o.reshape(o.shape[0], o.shape[1], A_HEADS * A_HEAD_DIM)


def gqa_context(q, k, v, sink):
    scale = A_HEAD_DIM ** -0.5
    def block(args):
        _, qb = args
        qg = qb.reshape(qb.shape[0], Q_BLOCK, A_KV_HEADS, A_GROUP, A_HEAD_DIM)
        s = jnp.einsum('bqkgd,bskd->bkgqs', qg, k).astype(F32) * scale
        return sink_softmax_av(s, sink, v)
    return map_query_blocks(block, q)


def gqa_window_latent(q, k, v, ctx_k, ctx_v, sink):
    n = q.shape[1]
    pad = ((0, 0), (Q_BLOCK, Q_BLOCK), (0, 0), (0, 0))
    kp, vp = jnp.pad(k, pad), jnp.pad(v, pad)
    scale = A_HEAD_DIM ** -0.5
    def block(args):
        i, qb = args
        start = i * Q_BLOCK
        kw = lax.dynamic_slice_in_dim(kp, start, 3 * Q_BLOCK, axis=1)
        vw = lax.dynamic_slice_in_dim(vp, start, 3 * Q_BLOCK, axis=1)
        qpos = start + jnp.arange(Q_BLOCK)
        kpos = start - Q_BLOCK + jnp.arange(3 * Q_BLOCK)
        valid = ((kpos >= 0) & (kpos < n))[None, :] & (jnp.abs(qpos[:, None] - kpos[None, :]) <= A_WINDOW)
        qg = qb.reshape(qb.shape[0], Q_BLOCK, A_KV_HEADS, A_GROUP, A_HEAD_DIM)
        s_loc = jnp.where(valid, jnp.einsum('bqkgd,bskd->bkgqs', qg, kw).astype(F32) * scale, NEG_INF)
        s_ctx = jnp.einsum('bqkgd,bskd->bkgqs', qg, ctx_k).astype(F32) * scale
        s = jnp.concatenate([s_loc, s_ctx], axis=-1)
        return sink_softmax_av(s, sink, jnp.concatenate([vw, ctx_v], axis=1))
    return map_query_blocks(block, q)


def mla_query(cq, lp):
    b, t = cq.shape[0], cq.shape[1]
    q = rms_norm(cq, lp['g_q']) @ lp['w_q_up']
    return q.reshape(b, t, B_HEADS, B_QK_DIM)


def mla_kv_up(ckv_n, lp):
    b, t = ckv_n.shape[0], ckv_n.shape[1]
    k_nope = (ckv_n @ lp['w_uk']).reshape(b, t, B_HEADS, B_NOPE)
    v = (ckv_n @ lp['w_uv']).reshape(b, t, B_HEADS, B_V_DIM)
    return k_nope, v


def mla_attend(q, k_nope, k_rope, v):
    scale = B_QK_DIM ** -0.5
    def block(args):
        _, qb = args
        qn, qr = qb[..., :B_NOPE], qb[..., B_NOPE:]
        s = (jnp.einsum('bqhd,bshd->bhqs', qn, k_nope).astype(F32)
             + jnp.einsum('bqhr,bsr->bhqs', qr, k_rope).astype(F32)) * scale
        p = jax.nn.softmax(s, axis=-1)
        o = jnp.einsum('bhqs,bshd->bqhd', p.astype(v.dtype), v)
        return o.reshape(o.shape[0], Q_BLOCK, B_HEADS * B_V_DIM)
    return map_query_blocks(block, q)


def centred_dwconv(x, w, bias):
    t = x.shape[1]
    xp = jnp.pad(x, ((0, 0), (1, C_CONV - 2), (0, 0)))
    out = bias
    for j in range(C_CONV):
        out = out + xp[:, j:j + t] * w[j]
    return out


def rglru(x, lam, w_a, b_a, w_i, b_i, h0):
    b, t, _ = x.shape
    xf = x.astype(F32)
    xb = xf.reshape(b, t, C_BLOCKS, C_BLOCK_W)
    r = jax.nn.sigmoid(jnp.einsum('btnc,ncd->btnd', xb, w_a.astype(F32)).reshape(b, t, C_WIDTH) + b_a.astype(F32))
    ig = jax.nn.sigmoid(jnp.einsum('btnc,ncd->btnd', xb, w_i.astype(F32)).reshape(b, t, C_WIDTH) + b_i.astype(F32))
    log_a = -C_RG * r * jax.nn.softplus(-lam.astype(F32))
    a = jnp.exp(log_a)
    u = jnp.sqrt(-jnp.expm1(2.0 * log_a)) * (ig * xf)
    u = u.at[:, 0].add(a[:, 0] * h0.astype(F32))
    def combine(e1, e2):
        a1, b1 = e1
        a2, b2 = e2
        return a1 * a2, a2 * b1 + b2
    _, h = lax.associative_scan(combine, (a, u), axis=1)
    return h


def rglru_bidir(x, lp, h0_fwd, h0_bwd):
    hf = rglru(x, lp['lam'][0], lp['w_ra'][0], lp['b_ra'][0], lp['w_ri'][0], lp['b_ri'][0], h0_fwd)
    hb = jnp.flip(rglru(jnp.flip(x, axis=1), lp['lam'][1], lp['w_ra'][1], lp['b_ra'][1],
                        lp['w_ri'][1], lp['b_ri'][1], h0_bwd), axis=1)
    return hf, hb


def merge_branches(ya, yb, yc, gl, lp):
    ys = jnp.stack([ya, yb, yc], axis=-2)
    proj = jnp.einsum('btnm,nmd->btnd', ys, lp['w_branch'])
    gates = jax.nn.sigmoid(gl.reshape(gl.shape[:-1] + (N_BRANCH, D_MODEL)))
    return jnp.sum(gates * proj, axis=-2) @ lp['w_out']


def mlp_sublayer(x, shift, scale, gate, lp):
    h = rms_norm(x, lp['g_pre2']) * (1 + scale) + shift
    f = jnp.square(jax.nn.relu(h @ lp['w_ff1'])) @ lp['w_ff2']
    return x + gate * rms_norm(f, lp['g_post2'])


def context_layer(x, c_ctx, lp):
    sh1, sc1, g1, sh2, sc2, g2 = ada(c_ctx[None, None, :], lp)
    b, s, _ = x.shape
    h = rms_norm(x, lp['g_pre1']) * (1 + sc1) + sh1
    qa, ka, va, cq, ckv, kr, xc, gc, gl = split_cols(h @ lp['w_in'])
    qa = qa.reshape(b, s, A_HEADS, A_HEAD_DIM)
    ka = ka.reshape(b, s, A_KV_HEADS, A_HEAD_DIM)
    va = va.reshape(b, s, A_KV_HEADS, A_HEAD_DIM)
    ya = gqa_context(qa, ka, va, lp['sink'])
    ckv_n = rms_norm(ckv, lp['g_kv'])
    kn, vb = mla_kv_up(ckv_n, lp)
    yb = mla_attend(mla_query(cq, lp), kn, kr, vb)
    xconv = centred_dwconv(xc, lp['w_conv'], lp['b_conv'])
    zero = jnp.zeros((b, C_WIDTH), F32)
    hf, hb = rglru_bidir(xconv, lp, zero, zero)
    yc = (jax.nn.gelu(gc.astype(F32)) * (hf + hb)).astype(x.dtype)
    x = x + g1 * rms_norm(merge_branches(ya, yb, yc, gl, lp), lp['g_post1'])
    x = mlp_sublayer(x, sh2, sc2, g2, lp)
    lru_state = jnp.stack([hf[:, -1], hb[:, 0]], axis=1).astype(x.dtype)
    return x, ka, va, ckv_n, kr, lru_state


def latent_layer(x, c, ctx_k, ctx_v, ctx_ckv, ctx_krope, lru0, rows, cols, lp):
    sh1, sc1, g1, sh2, sc2, g2 = ada(c[:, None, :], lp)
    b, n, _ = x.shape
    h = rms_norm(x, lp['g_pre1']) * (1 + sc1) + sh1
    qa, ka, va, cq, ckv, kr, xc, gc, gl = split_cols(h @ lp['w_in'])
    qa = axial_rope(qa.reshape(b, n, A_HEADS, A_HEAD_DIM), rows, cols)
    ka = axial_rope(ka.reshape(b, n, A_KV_HEADS, A_HEAD_DIM), rows, cols)
    va = va.reshape(b, n, A_KV_HEADS, A_HEAD_DIM)
    ya = gqa_window_latent(qa, ka, va, ctx_k, ctx_v, lp['sink'])
    qb = mla_query(cq, lp)
    qb = jnp.concatenate([qb[..., :B_NOPE], axial_rope(qb[..., B_NOPE:], rows, cols)], axis=-1)
    kr_lat = axial_rope(kr[:, :, None, :], rows, cols)[:, :, 0]
    kn_lat, v_lat = mla_kv_up(rms_norm(ckv, lp['g_kv']), lp)
    kn_ctx, v_ctx = mla_kv_up(ctx_ckv, lp)
    yb = mla_attend(qb, jnp.concatenate([kn_lat, kn_ctx], axis=1),
                    jnp.concatenate([kr_lat, ctx_krope], axis=1),
                    jnp.concatenate([v_lat, v_ctx], axis=1))
    xconv = centred_dwconv(xc, lp['w_conv'], lp['b_conv'])
    hf, hb = rglru_bidir(xconv, lp, lru0[:, 0], lru0[:, 1])
    yc = (jax.nn.gelu(gc.astype(F32)) * (hf + hb)).astype(x.dtype)
    x = x + g1 * rms_norm(merge_branches(ya, yb, yc, gl, lp), lp['g_post1'])
    return mlp_sublayer(x, sh2, sc2, g2, lp)


def setup_inputs(seed: int = 0) -> dict:
    key = jax.random.key(seed)
    ks = jax.random.split(key, 40)
    def nrm(k, shape, scale):
        return jax.random.normal(k, shape, F32) * scale
    def gain(k, shape):
        return 1.0 + 0.05 * jax.random.normal(k, shape, F32)
    u = jax.random.uniform(ks[20], (DEPTH, 2, C_WIDTH), F32, minval=0.9, maxval=0.999)
    a_base = u ** (1.0 / C_RG)
    lam = jnp.log(a_base) - jnp.log1p(-a_base)
    return {
        'x_prompt': nrm(ks[0], (BATCH, SEQ, D_MODEL), 1.0),
        'x_sample': nrm(ks[1], (DEC_BATCH, DEC_SEQ, D_MODEL), 1.0),
        'cache_attn_k': nrm(ks[2], (DEC_BATCH, DEPTH, PAST_LEN, A_KV_HEADS, A_HEAD_DIM), 1.0),
        'cache_attn_v': nrm(ks[3], (DEC_BATCH, DEPTH, PAST_LEN, A_KV_HEADS, A_HEAD_DIM), 1.0),
        'cache_mla_ckv': nrm(ks[4], (DEC_BATCH, DEPTH, PAST_LEN, B_KV_LORA), 1.0),
        'cache_mla_krope': nrm(ks[5], (DEC_BATCH, DEPTH, PAST_LEN, B_ROPE), 1.0),
        'state_lru': nrm(ks[6], (DEC_BATCH, DEPTH, 2, C_WIDTH), 0.5),
        'c': nrm(ks[7], (DEC_BATCH, D_MODEL), 1.0),
        'c_ctx': nrm(ks[8], (D_MODEL,), 1.0),
        'w_ada': nrm(ks[9], (DEPTH, D_MODEL, N_ADA * D_MODEL), D_MODEL ** -0.5),
        'b_ada': nrm(ks[10], (DEPTH, N_ADA * D_MODEL), 0.02),
        'g_pre1': gain(ks[11], (DEPTH, D_MODEL)),
        'g_post1': gain(ks[12], (DEPTH, D_MODEL)),
        'g_pre2': gain(ks[13], (DEPTH, D_MODEL)),
        'g_post2': gain(ks[14], (DEPTH, D_MODEL)),
        'w_in': nrm(ks[15], (DEPTH, D_MODEL, IN_COLS), D_MODEL ** -0.5),
        'sink': nrm(ks[16], (DEPTH, A_HEADS), 0.5),
        'g_q': gain(ks[17], (DEPTH, B_Q_LORA)),
        'w_q_up': nrm(ks[18], (DEPTH, B_Q_LORA, B_HEADS * B_QK_DIM), B_Q_LORA ** -0.5),
        'g_kv': gain(ks[19], (DEPTH, B_KV_LORA)),
        'w_uk': nrm(ks[21], (DEPTH, B_KV_LORA, B_HEADS * B_NOPE), B_KV_LORA ** -0.5),
        'w_uv': nrm(ks[22], (DEPTH, B_KV_LORA, B_HEADS * B_V_DIM), B_KV_LORA ** -0.5),
        'w_conv': nrm(ks[23], (DEPTH, C_CONV, C_WIDTH), C_CONV ** -0.5),
        'b_conv': nrm(ks[24], (DEPTH, C_WIDTH), 0.02),
        'lam': lam,
        'w_ra': nrm(ks[25], (DEPTH, 2, C_BLOCKS, C_BLOCK_W, C_BLOCK_W), C_BLOCK_W ** -0.5),
        'b_ra': nrm(ks[26], (DEPTH, 2, C_WIDTH), 0.02),
        'w_ri': nrm(ks[27], (DEPTH, 2, C_BLOCKS, C_BLOCK_W, C_BLOCK_W), C_BLOCK_W ** -0.5),
        'b_ri': nrm(ks[28], (DEPTH, 2, C_WIDTH), 0.02),
        'w_branch': nrm(ks[29], (DEPTH, N_BRANCH, MIX_W, D_MODEL), MIX_W ** -0.5),
        'w_out': nrm(ks[30], (DEPTH, D_MODEL, D_MODEL), D_MODEL ** -0.5),
        'w_ff1': nrm(ks[31], (DEPTH, D_MODEL, D_FF), D_MODEL ** -0.5),
        'w_ff2': nrm(ks[32], (DEPTH, D_FF, D_MODEL), D_FF ** -0.5),
    }


def reference(x_prompt, x_sample, cache_attn_k, cache_attn_v, cache_mla_ckv, cache_mla_krope, state_lru,
              c, c_ctx, w_ada, b_ada, g_pre1, g_post1, g_pre2, g_post2, w_in, sink, g_q, w_q_up,
              g_kv, w_uk, w_uv, w_conv, b_conv, lam, w_ra, b_ra, w_ri, b_ri, w_branch, w_out,
              w_ff1, w_ff2):
    n = x_sample.shape[1]
    n_rows = n // GRID_W
    rows = jnp.repeat(jnp.arange(n_rows), GRID_W)
    cols = jnp.arange(n_rows * GRID_W) % GRID_W
    y_p = x_prompt
    y_s = x_sample
    ks_l, vs_l, ckv_l, kr_l, st_l = [], [], [], [], []
    for l in range(DEPTH):
        lp = dict(w_ada=w_ada[l], b_ada=b_ada[l], g_pre1=g_pre1[l], g_post1=g_post1[l],
                  g_pre2=g_pre2[l], g_post2=g_post2[l], w_in=w_in[l], sink=sink[l], g_q=g_q[l],
                  w_q_up=w_q_up[l], g_kv=g_kv[l], w_uk=w_uk[l], w_uv=w_uv[l], w_conv=w_conv[l],
                  b_conv=b_conv[l], lam=lam[l], w_ra=w_ra[l], b_ra=b_ra[l], w_ri=w_ri[l], b_ri=b_ri[l],
                  w_branch=w_branch[l], w_out=w_out[l], w_ff1=w_ff1[l], w_ff2=w_ff2[l])
        y_p, k_new, v_new, ckv_new, kr_new, st_new = context_layer(y_p, c_ctx, lp)
        ks_l.append(k_new)
        vs_l.append(v_new)
        ckv_l.append(ckv_new)
        kr_l.append(kr_new)
        st_l.append(st_new)
        y_s = latent_layer(y_s, c, cache_attn_k[:, l], cache_attn_v[:, l], cache_mla_ckv[:, l],
                           cache_mla_krope[:, l], state_lru[:, l], rows, cols, lp)
    new_attn_k = jnp.stack(ks_l, axis=1)
    new_attn_v = jnp.stack(vs_l, axis=1)
    new_mla_ckv = jnp.stack(ckv_l, axis=1)
    new_mla_krope = jnp.stack(kr_l, axis=1)
    new_state_lru = jnp.stack(st_l, axis=1)
    return (y_p, y_s, new_attn_k, new_attn_v, new_mla_ckv, new_mla_krope, new_state_lru)
```

```cpp
#include <hip/hip_runtime.h>
#include <hip/hip_cooperative_groups.h>
#include <stdint.h>
#include <stdio.h>
namespace cg = cooperative_groups;

#define DI __device__ __forceinline__
#define GSYNC() xcd_barrier(xb)
#define DBG_SKIP_FF2 0
#define DBG_NOROPE 0
#ifndef REP_GEMM
#define REP_GEMM 1
#endif
#ifndef REP_MLA
#define REP_MLA 1
#endif
#ifndef REP_SCAN
#define REP_SCAN 1
#endif
#ifndef PHASE_MASK
#define PHASE_MASK 0xFFFF
#endif
typedef unsigned short u16;
typedef __attribute__((ext_vector_type(8))) short bf16x8;
typedef __attribute__((ext_vector_type(16))) float f32x16;
typedef __attribute__((ext_vector_type(2))) float f32x2;
typedef __attribute__((ext_vector_type(2))) __bf16 bf2_t;

constexpr int DM = 1024, T = 20480, TC = 22528, NCTX = 4096, DEPTH = 4;
constexpr int PW = 2464;
constexpr int PP = 2496;
constexpr int C_QA = 0, C_KA = 512, C_VA = 640, C_CQ = 768, C_CKV = 1152, C_KR = 1408, C_XC = 1440, C_GC = 1952, C_GL = 2464;
constexpr int INC = 5536;
constexpr float EPS = 1e-6f;
constexpr float LOG2E = 1.4426950408889634f;

constexpr size_t O_Y = 0, O_K = 20971520, O_V = 23068672, O_CKV = 25165824, O_KR = 29360128, O_ST = 29884416;

constexpr size_t al256(size_t x) { return (x + 255) & ~(size_t)255; }
constexpr size_t WS_BAR = 0;
constexpr size_t WS_CTR = 16384;
constexpr size_t WS_MOD = 65536;
constexpr size_t WS_ZERO_BYTES = 65536;
constexpr size_t WS_MOD_END = WS_MOD + (size_t)4 * 5 * 6144 * 4;
constexpr size_t WS_TAB16 = al256(WS_MOD_END);
constexpr size_t WS_TAB8 = WS_TAB16 + 64 * 16 * 8;
constexpr size_t WS_CK = al256(WS_TAB8 + 64 * 8 * 8);
constexpr size_t WS_CKR = WS_CK + (size_t)16 * 512 * 128 * 2;
constexpr size_t WS_VCT = WS_CKR + (size_t)16 * 512 * 32 * 2;
constexpr size_t WS_WT = al256(WS_VCT + (size_t)16 * 2 * 64 * 512 * 2);
constexpr size_t WT_IN = 0;
constexpr size_t WT_QUP = WT_IN + (size_t)5536 * 1024;
constexpr size_t WT_KV = WT_QUP + (size_t)768 * 384;
constexpr size_t WT_G = WT_KV + (size_t)1024 * 256;
constexpr size_t WT_BR = WT_G + (size_t)8 * 256 * 64;
constexpr size_t WT_OUT = WT_BR + (size_t)3 * 1024 * 512;
constexpr size_t WT_FF1 = WT_OUT + (size_t)1024 * 1024;
constexpr size_t WT_FF2 = WT_FF1 + (size_t)4096 * 1024;
constexpr size_t WT_ELEMS = WT_FF2 + (size_t)1024 * 4096;
constexpr size_t WS_H = al256(WS_WT + WT_ELEMS * 2);
constexpr size_t WS_P = al256(WS_H + (size_t)T * 1024 * 2);
constexpr size_t WS_G = WS_P + (size_t)T * PP * 2;
constexpr size_t WS_CKVN = al256(WS_G + (size_t)T * 2048 * 2);
constexpr size_t WS_XCV = WS_CKVN + (size_t)TC * 256 * 2;
constexpr size_t WS_QB = al256(WS_XCV + (size_t)T * 512 * 2);
constexpr size_t WS_KN = WS_QB + (size_t)T * 768 * 2;
constexpr size_t WS_VML = al256(WS_KN + (size_t)TC * 512 * 2);
constexpr size_t WS_VMC = WS_VML + (size_t)4 * 8 * 64 * 4608 * 2;
constexpr size_t WS_VGL = WS_VMC + (size_t)16 * 8 * 64 * 256 * 2;
constexpr size_t WS_VGC = WS_VGL + (size_t)4 * 2 * 64 * 4608 * 2;
constexpr size_t WS_YA = al256(WS_VGC + (size_t)16 * 2 * 64 * 256 * 2);
constexpr size_t WS_YB = WS_YA + (size_t)T * 512 * 2;
constexpr size_t WS_YC = WS_YB + (size_t)T * 512 * 2;
constexpr size_t WS_SUM = al256(WS_YC + (size_t)T * 512 * 2);
constexpr size_t WS_END = WS_SUM + (size_t)20 * 8 * 32 * 256 * 4;
constexpr size_t WS_F1 = WS_P;
constexpr size_t WS_MO = WS_G;
constexpr size_t WS_M = WS_QB;

struct Params {
  const float* in[33];
  float* out;
  char* ws;
};

DI int tid_l() { int t = threadIdx.x; asm volatile("" : "+v"(t)); return t; }
DI float bf2f(u16 v) { return __uint_as_float(((unsigned)v) << 16); }
DI unsigned pk2(float a, float b) {
  f32x2 v = {a, b};
  bf2_t r = __builtin_convertvector(v, bf2_t);
  return __builtin_bit_cast(unsigned, r);
}
DI u16 f2bf(float a) { return (u16)(pk2(a, 0.f) & 0xffffu); }
DI float lo_bf(unsigned u) { return __uint_as_float(u << 16); }
DI float hi_bf(unsigned u) { return __uint_as_float(u & 0xffff0000u); }
DI float wsum(float v) {
#pragma unroll
  for (int o = 32; o > 0; o >>= 1) v += __shfl_xor(v, o, 64);
  return v;
}
DI float sigmoidf_(float x) { return 1.f / (1.f + __expf(-x)); }
DI int grp_of(int r) { return r < NCTX ? 0 : 1 + ((r - NCTX) >> 12); }
DI const float* xin_row(const Params& p, int r) {
  return r < NCTX ? p.in[0] + (size_t)r * DM : p.in[1] + (size_t)(r - NCTX) * DM;
}
#define MFMA32(a, b, c) __builtin_amdgcn_mfma_f32_32x32x16_bf16((a), (b), (c), 0, 0, 0)

constexpr int LROW = 72;
constexpr int SMEM_BYTES = 4 * 128 * LROW * 2;

template <int TN>
struct GStage {
  uint4 a[4];
  uint4 b[2 * TN];
};
template <int TN>
DI void g_load(GStage<TN>& st, const u16* pa, int lda, const u16* const (&pb)[2 * TN], int k0) {
#pragma unroll
  for (int i = 0; i < 4; ++i) st.a[i] = *(const uint4*)(pa + (size_t)(32 * i) * lda + k0);
#pragma unroll
  for (int i = 0; i < 2 * TN; ++i) st.b[i] = *(const uint4*)(pb[i] + k0);
}
template <int TN>
DI void g_store(const GStage<TN>& st, u16* sA, u16* sB, int buf, int lrow, int lch) {
#pragma unroll
  for (int i = 0; i < 4; ++i) *(uint4*)(sA + (buf * 128 + lrow + 32 * i) * LROW + lch * 8) = st.a[i];
#pragma unroll
  for (int i = 0; i < 2 * TN; ++i) *(uint4*)(sB + (buf * 128 + lrow + 32 * i) * LROW + lch * 8) = st.b[i];
}
template <int TN>
DI void g_mma(const u16* sA, const u16* sB, int buf, int wm, int wn, int r, int h, f32x16 (&acc)[2][TN]) {
  const u16* cA = sA + (buf * 128 + wm * 64 + r) * LROW + h * 8;
  const u16* cB = sB + (buf * 128 + wn * 32 * TN + r) * LROW + h * 8;
#pragma unroll
  for (int ks = 0; ks < 4; ++ks) {
    bf16x8 a_[2], b_[TN];
#pragma unroll
    for (int i = 0; i < 2; ++i) a_[i] = *(const bf16x8*)(cA + i * 32 * LROW + ks * 16);
#pragma unroll
    for (int j = 0; j < TN; ++j) b_[j] = *(const bf16x8*)(cB + j * 32 * LROW + ks * 16);
#pragma unroll
    for (int i = 0; i < 2; ++i)
#pragma unroll
      for (int j = 0; j < TN; ++j) acc[i][j] = MFMA32(a_[i], b_[j], acc[i][j]);
  }
}

template <int TN>
DI void gemm_mainloop(const u16* __restrict__ A, int lda, const u16* __restrict__ B, int ldb, int nvalid, int K,
                      u16* smem, f32x16 (&acc)[2][TN]) {
  static_assert(TN == 2, "only the 128x128 tile is used");
  const int tid = tid_l(), lane = tid & 63, wave = tid >> 6;
  const int r = lane & 31, h = lane >> 5;
  const int wm = wave >> 1, wn = wave & 1;
  u16* sA = smem;
  u16* sB = smem + 2 * 128 * LROW;
  const int lrow = tid >> 3, lch = tid & 7;
  const u16* pa = A + (size_t)lrow * lda + lch * 8;
  (void)nvalid;
  const u16* pb = B + (size_t)lrow * ldb + lch * 8;
  const int nk = K >> 6, kmax = K - 64;
  u16* wA = sA + lrow * LROW + lch * 8;
  u16* wB = sB + lrow * LROW + lch * 8;
  uint4 xa0, xa1, xa2, xa3, xb0, xb1, xb2, xb3, ya0, ya1, ya2, ya3, yb0, yb1, yb2, yb3;
  {
    const uint4 t0 = *(const uint4*)(pa), t1 = *(const uint4*)(pa + (size_t)32 * lda), t2 = *(const uint4*)(pa + (size_t)64 * lda),
                t3 = *(const uint4*)(pa + (size_t)96 * lda);
    const uint4 u0 = *(const uint4*)(pb), u1 = *(const uint4*)(pb + (size_t)32 * ldb), u2 = *(const uint4*)(pb + (size_t)64 * ldb), u3 = *(const uint4*)(pb + (size_t)96 * ldb);
    *(uint4*)(wA) = t0; *(uint4*)(wA + 32 * LROW) = t1; *(uint4*)(wA + 64 * LROW) = t2; *(uint4*)(wA + 96 * LROW) = t3;
    *(uint4*)(wB) = u0; *(uint4*)(wB + 32 * LROW) = u1; *(uint4*)(wB + 64 * LROW) = u2; *(uint4*)(wB + 96 * LROW) = u3;
  }
  if (nk == 1) {
    __syncthreads();
#pragma unroll
    for (int q = 0; q < 4; ++q) {
      const u16* cA_ = sA + (wm * 64 + r) * LROW + h * 8 + q * 16;
      const u16* cB_ = sB + (wn * 64 + r) * LROW + h * 8 + q * 16;
      const bf16x8 fa0 = *(const bf16x8*)(cA_), fa1 = *(const bf16x8*)(cA_ + 32 * LROW);
      const bf16x8 fb0 = *(const bf16x8*)(cB_), fb1 = *(const bf16x8*)(cB_ + 32 * LROW);
      acc[0][0] = MFMA32(fa0, fb0, acc[0][0]);
      acc[0][1] = MFMA32(fa0, fb1, acc[0][1]);
      acc[1][0] = MFMA32(fa1, fb0, acc[1][0]);
      acc[1][1] = MFMA32(fa1, fb1, acc[1][1]);
    }
    __syncthreads();
    return;
  }
  {
    const int k1 = 64 < kmax ? 64 : kmax, k2 = 128 < kmax ? 128 : kmax;
    xa0 = *(const uint4*)(pa + k1); xa1 = *(const uint4*)(pa + (size_t)32 * lda + k1);
    xa2 = *(const uint4*)(pa + (size_t)64 * lda + k1); xa3 = *(const uint4*)(pa + (size_t)96 * lda + k1);
    xb0 = *(const uint4*)(pb + k1); xb1 = *(const uint4*)(pb + (size_t)32 * ldb + k1); xb2 = *(const uint4*)(pb + (size_t)64 * ldb + k1); xb3 = *(const uint4*)(pb + (size_t)96 * ldb + k1);
    ya0 = *(const uint4*)(pa + k2); ya1 = *(const uint4*)(pa + (size_t)32 * lda + k2);
    ya2 = *(const uint4*)(pa + (size_t)64 * lda + k2); ya3 = *(const uint4*)(pa + (size_t)96 * lda + k2);
    yb0 = *(const uint4*)(pb + k2); yb1 = *(const uint4*)(pb + (size_t)32 * ldb + k2); yb2 = *(const uint4*)(pb + (size_t)64 * ldb + k2); yb3 = *(const uint4*)(pb + (size_t)96 * ldb + k2);
  }
  __syncthreads();
#define SUBSTEPM(S, Q, BUF, OK)                                                                               \
  {                                                                                                           \
    const u16* cA_ = sA + ((BUF) * 128 + wm * 64 + r) * LROW + h * 8 + (Q) * 16;                              \
    const u16* cB_ = sB + ((BUF) * 128 + wn * 64 + r) * LROW + h * 8 + (Q) * 16;                              \
    const bf16x8 fa0 = *(const bf16x8*)(cA_), fa1 = *(const bf16x8*)(cA_ + 32 * LROW);                        \
    const bf16x8 fb0 = *(const bf16x8*)(cB_), fb1 = *(const bf16x8*)(cB_ + 32 * LROW);                        \
    acc[0][0] = MFMA32(fa0, fb0, acc[0][0]);                                                                  \
    acc[0][1] = MFMA32(fa0, fb1, acc[0][1]);                                                                  \
    acc[1][0] = MFMA32(fa1, fb0, acc[1][0]);                                                                  \
    acc[1][1] = MFMA32(fa1, fb1, acc[1][1]);                                                                  \
    *(uint4*)(wA + (((BUF) ^ 1) * 128 + 32 * (Q)) * LROW) = S##a##Q;                                          \
    *(uint4*)(wB + (((BUF) ^ 1) * 128 + 32 * (Q)) * LROW) = S##b##Q;                                          \
    S##a##Q = *(const uint4*)(pa + (size_t)(32 * (Q)) * lda + (OK));                                          \
    S##b##Q = *(const uint4*)(pb + (size_t)(32 * (Q)) * ldb + (OK));                                                                  \
  }
  for (int kt = 0; kt < nk; kt += 2) {
    {
      const int ok = ((kt + 3) << 6) < kmax ? ((kt + 3) << 6) : kmax;
      SUBSTEPM(x, 0, 0, ok) SUBSTEPM(x, 1, 0, ok) SUBSTEPM(x, 2, 0, ok) SUBSTEPM(x, 3, 0, ok)
      __syncthreads();
    }
    if (kt + 1 < nk) {
      const int ok = ((kt + 4) << 6) < kmax ? ((kt + 4) << 6) : kmax;
      SUBSTEPM(y, 0, 1, ok) SUBSTEPM(y, 1, 1, ok) SUBSTEPM(y, 2, 1, ok) SUBSTEPM(y, 3, 1, ok)
      __syncthreads();
    }
  }
#undef SUBSTEPM
}

struct GCarry {
  uint4 xa0, xa1, xa2, xa3, xb0, xb1, xb2, xb3, ya0, ya1, ya2, ya3, yb0, yb1, yb2, yb3;
};
DI void gemm_stream(bool first, GCarry& c, const u16* __restrict__ A, int lda, const u16* __restrict__ B, int ldb, int  ,
                    const u16* __restrict__ An, const u16* __restrict__ Bn, int  , int K, u16* smem,
                    f32x16 (&acc)[2][2]) {
  const int tid = tid_l(), lane = tid & 63, wave = tid >> 6;
  const int r = lane & 31, h = lane >> 5;
  const int wm = wave >> 1, wn = wave & 1;
  u16* sA = smem;
  u16* sB = smem + 2 * 128 * LROW;
  const int lrow = tid >> 3, lch = tid & 7;
  const u16* pa = A + (size_t)lrow * lda + lch * 8;
  const u16* pb = B + (size_t)lrow * ldb + lch * 8;
  const long dA = An - A, dB = Bn - B;
  const int nk = K >> 6;
  uint4 xa0 = c.xa0, xa1 = c.xa1, xa2 = c.xa2, xa3 = c.xa3, xb0 = c.xb0, xb1 = c.xb1, xb2 = c.xb2, xb3 = c.xb3;
  uint4 ya0 = c.ya0, ya1 = c.ya1, ya2 = c.ya2, ya3 = c.ya3, yb0 = c.yb0, yb1 = c.yb1, yb2 = c.yb2, yb3 = c.yb3;
  u16* wA = sA + lrow * LROW + lch * 8;
  u16* wB = sB + lrow * LROW + lch * 8;
  if (first) {
    {
      const uint4 t0 = *(const uint4*)(pa), t1 = *(const uint4*)(pa + (size_t)32 * lda), t2 = *(const uint4*)(pa + (size_t)64 * lda),
                  t3 = *(const uint4*)(pa + (size_t)96 * lda);
      const uint4 u0 = *(const uint4*)(pb), u1 = *(const uint4*)(pb + (size_t)32 * ldb), u2 = *(const uint4*)(pb + (size_t)64 * ldb),
                  u3 = *(const uint4*)(pb + (size_t)96 * ldb);
      *(uint4*)(wA) = t0; *(uint4*)(wA + 32 * LROW) = t1; *(uint4*)(wA + 64 * LROW) = t2; *(uint4*)(wA + 96 * LROW) = t3;
      *(uint4*)(wB) = u0; *(uint4*)(wB + 32 * LROW) = u1; *(uint4*)(wB + 64 * LROW) = u2; *(uint4*)(wB + 96 * LROW) = u3;
    }
    xa0 = *(const uint4*)(pa + 64); xa1 = *(const uint4*)(pa + (size_t)32 * lda + 64);
    xa2 = *(const uint4*)(pa + (size_t)64 * lda + 64); xa3 = *(const uint4*)(pa + (size_t)96 * lda + 64);
    xb0 = *(const uint4*)(pb + 64); xb1 = *(const uint4*)(pb + (size_t)32 * ldb + 64);
    xb2 = *(const uint4*)(pb + (size_t)64 * ldb + 64); xb3 = *(const uint4*)(pb + (size_t)96 * ldb + 64);
    ya0 = *(const uint4*)(pa + 128); ya1 = *(const uint4*)(pa + (size_t)32 * lda + 128);
    ya2 = *(const uint4*)(pa + (size_t)64 * lda + 128); ya3 = *(const uint4*)(pa + (size_t)96 * lda + 128);
    yb0 = *(const uint4*)(pb + 128); yb1 = *(const uint4*)(pb + (size_t)32 * ldb + 128);
    yb2 = *(const uint4*)(pb + (size_t)64 * ldb + 128); yb3 = *(const uint4*)(pb + (size_t)96 * ldb + 128);
    __syncthreads();
  }
#define SUBSTEP(S, Q, BUF, OA, OB)                                                                            \
  {                                                                                                           \
    const u16* cA_ = sA + ((BUF) * 128 + wm * 64 + r) * LROW + h * 8 + (Q) * 16;                              \
    const u16* cB_ = sB + ((BUF) * 128 + wn * 64 + r) * LROW + h * 8 + (Q) * 16;                              \
    const bf16x8 fa0 = *(const bf16x8*)(cA_), fa1 = *(const bf16x8*)(cA_ + 32 * LROW);                        \
    const bf16x8 fb0 = *(const bf16x8*)(cB_), fb1 = *(const bf16x8*)(cB_ + 32 * LROW);                        \
    acc[0][0] = MFMA32(fa0, fb0, acc[0][0]);                                                                  \
    acc[0][1] = MFMA32(fa0, fb1, acc[0][1]);                                                                  \
    acc[1][0] = MFMA32(fa1, fb0, acc[1][0]);                                                                  \
    acc[1][1] = MFMA32(fa1, fb1, acc[1][1]);                                                                  \
    *(uint4*)(wA + (((BUF) ^ 1) * 128 + 32 * (Q)) * LROW) = S##a##Q;                                          \
    *(uint4*)(wB + (((BUF) ^ 1) * 128 + 32 * (Q)) * LROW) = S##b##Q;                                          \
    S##a##Q = *(const uint4*)(pa + (size_t)(32 * (Q)) * lda + (OA));                                          \
    S##b##Q = *(const uint4*)(pb + (size_t)(32 * (Q)) * ldb + (OB));                                          \
  }
  for (int kt = 0; kt < nk; kt += 2) {
    {
      const int j = kt + 3;
      const long oA = j < nk ? (long)j * 64 : dA + (long)(j - nk) * 64, oB = j < nk ? (long)j * 64 : dB + (long)(j - nk) * 64;
      SUBSTEP(x, 0, 0, oA, oB) SUBSTEP(x, 1, 0, oA, oB) SUBSTEP(x, 2, 0, oA, oB) SUBSTEP(x, 3, 0, oA, oB)
      __syncthreads();
    }
    {
      const int j = kt + 4;
      const long oA = j < nk ? (long)j * 64 : dA + (long)(j - nk) * 64, oB = j < nk ? (long)j * 64 : dB + (long)(j - nk) * 64;
      SUBSTEP(y, 0, 1, oA, oB) SUBSTEP(y, 1, 1, oA, oB) SUBSTEP(y, 2, 1, oA, oB) SUBSTEP(y, 3, 1, oA, oB)
      __syncthreads();
    }
  }
#undef SUBSTEP
  c.xa0 = xa0; c.xa1 = xa1; c.xa2 = xa2; c.xa3 = xa3; c.xb0 = xb0; c.xb1 = xb1; c.xb2 = xb2; c.xb3 = xb3;
  c.ya0 = ya0; c.ya1 = ya1; c.ya2 = ya2; c.ya3 = ya3; c.yb0 = yb0; c.yb1 = yb1; c.yb2 = yb2; c.yb3 = yb3;
}

template <int TN>
DI void zero_acc(f32x16 (&acc)[2][TN]) {
#pragma unroll
  for (int i = 0; i < 2; ++i)
#pragma unroll
    for (int j = 0; j < TN; ++j)
#pragma unroll
      for (int e = 0; e < 16; ++e) acc[i][j][e] = 0.f;
}

template <int TN, class Epi>
DI void gemm_epilogue(f32x16 (&acc)[2][TN], Epi epi) {
  const int tid = tid_l(), lane = tid & 63, wave = tid >> 6;
  const int r = lane & 31, h = lane >> 5;
  const int wm = wave >> 1, wn = wave & 1;
#pragma unroll
  for (int i = 0; i < 2; ++i)
#pragma unroll
    for (int j = 0; j < TN; ++j)
#pragma unroll
      for (int g = 0; g < 4; ++g)
        epi(wm * 64 + i * 32 + 8 * g + 4 * h, wn * 32 * TN + j * 32 + r, acc[i][j][4 * g], acc[i][j][4 * g + 1],
            acc[i][j][4 * g + 2], acc[i][j][4 * g + 3]);
}

DI void transpose_tile(const float* __restrict__ src, int ldn, u16* __restrict__ dst, int ldk, int tk, int tn, float* sT) {
  const int tid = tid_l();
  {
    const int kk = tid >> 3, n4 = (tid & 7) * 4;
#pragma unroll
    for (int ps = 0; ps < 2; ++ps) {
      typedef __attribute__((ext_vector_type(4))) float f32x4_t;
      const f32x4_t v = __builtin_nontemporal_load((const f32x4_t*)(src + (size_t)(tk * 64 + kk + 32 * ps) * ldn + tn * 32 + n4));
      sT[(n4 + 0) * 65 + kk + 32 * ps] = v.x;
      sT[(n4 + 1) * 65 + kk + 32 * ps] = v.y;
      sT[(n4 + 2) * 65 + kk + 32 * ps] = v.z;
      sT[(n4 + 3) * 65 + kk + 32 * ps] = v.w;
    }
  }
  __syncthreads();
  {
    const int n = tid >> 3, k8 = (tid & 7) * 8;
    const float* s = sT + n * 65 + k8;
    uint4 o;
    o.x = pk2(s[0], s[1]);
    o.y = pk2(s[2], s[3]);
    o.z = pk2(s[4], s[5]);
    o.w = pk2(s[6], s[7]);
    *(uint4*)(dst + (size_t)(tn * 32 + n) * ldk + tk * 64 + k8) = o;
  }
  __syncthreads();
}

DI void transpose_job(const float* src, int ldn, u16* dst, int ldk, int K, int N, float* sT, int rot) {
  const int ntk = K >> 6, nt = ntk * (N >> 5);
  int start = (int)blockIdx.x - rot;
  if (start < 0) start += gridDim.x;
  for (int t = start; t < nt; t += gridDim.x) transpose_tile(src, ldn, dst, ldk, t % ntk, t / ntk, sT);
}

DI void transpose_layer(const Params& p, int l, float* sT) {
  u16* wt = (u16*)(p.ws + WS_WT);
  const int G = gridDim.x;
  int rot = 0;
  transpose_job(p.in[15] + (size_t)l * 1024 * INC, INC, wt + WT_IN, 1024, 1024, INC, sT, rot);
  rot = (rot + 16 * 173) % G;
  transpose_job(p.in[18] + (size_t)l * 384 * 768, 768, wt + WT_QUP, 384, 384, 768, sT, rot);
  rot = (rot + 6 * 24) % G;
  transpose_job(p.in[20] + (size_t)l * 256 * 512, 512, wt + WT_KV, 256, 256, 512, sT, rot);
  rot = (rot + 4 * 16) % G;
  transpose_job(p.in[21] + (size_t)l * 256 * 512, 512, wt + WT_KV + (size_t)512 * 256, 256, 256, 512, sT, rot);
  rot = (rot + 4 * 16) % G;
  {
    int start = (int)blockIdx.x - rot;
    if (start < 0) start += G;
    for (int t = start; t < 64; t += G) {
      const int job = t >> 1, tn = t & 1;
      const int n = job & 7, which = (job >> 3) & 1, dir = job >> 4;
      const float* src = (which ? p.in[27] : p.in[25]) + (size_t)(((l * 2 + dir) * 8 + n)) * 4096;
      transpose_tile(src, 64, wt + WT_G + (size_t)(n * 256 + (dir * 2 + which) * 64) * 64, 64, 0, tn, sT);
    }
    rot = (rot + 64) % G;
  }
  for (int n = 0; n < 3; ++n) {
    transpose_job(p.in[29] + (size_t)(l * 3 + n) * 512 * 1024, 1024, wt + WT_BR + (size_t)n * 1024 * 512, 512, 512, 1024, sT, rot);
    rot = (rot + 8 * 32) % G;
  }
  transpose_job(p.in[30] + (size_t)l * 1024 * 1024, 1024, wt + WT_OUT, 1024, 1024, 1024, sT, rot);
  rot = (rot + 16 * 32) % G;
  if (l == 0 || !DBG_SKIP_FF2) transpose_job(p.in[31] + (size_t)l * 1024 * 4096, 4096, wt + WT_FF1, 1024, 1024, 4096, sT, rot);
  rot = (rot + 16 * 128) % G;
  if (l == 0 || !DBG_SKIP_FF2) transpose_job(p.in[32] + (size_t)l * 4096 * 1024, 1024, wt + WT_FF2, 4096, 4096, 1024, sT, rot);
}

DI void row_resnorm(int r, const float* xrow, const u16* f, const float* gpost, const float* gate, const float* gpre,
                    const float* sc, const float* sh, float* outx, u16* outh, int lane) {
  float x[16];
#pragma unroll
  for (int i = 0; i < 4; ++i) {
    const float4 v = *(const float4*)(xrow + (i * 64 + lane) * 4);
    x[4 * i] = v.x; x[4 * i + 1] = v.y; x[4 * i + 2] = v.z; x[4 * i + 3] = v.w;
  }
  if (f) {
    float fv[16];
    float ss = 0.f;
#pragma unroll
    for (int i = 0; i < 4; ++i) {
      const uint2 u = *(const uint2*)(f + (size_t)r * DM + (i * 64 + lane) * 4);
      fv[4 * i] = lo_bf(u.x); fv[4 * i + 1] = hi_bf(u.x); fv[4 * i + 2] = lo_bf(u.y); fv[4 * i + 3] = hi_bf(u.y);
    }
#pragma unroll
    for (int i = 0; i < 16; ++i) ss += fv[i] * fv[i];
    ss = wsum(ss);
    const float rstd = rsqrtf(ss * (1.f / DM) + EPS);
#pragma unroll
    for (int i = 0; i < 4; ++i) {
      const int idx = (i * 64 + lane) * 4;
      const float4 gp = *(const float4*)(gpost + idx);
      const float4 gt = *(const float4*)(gate + idx);
      x[4 * i] += gt.x * (fv[4 * i] * rstd * gp.x);
      x[4 * i + 1] += gt.y * (fv[4 * i + 1] * rstd * gp.y);
      x[4 * i + 2] += gt.z * (fv[4 * i + 2] * rstd * gp.z);
      x[4 * i + 3] += gt.w * (fv[4 * i + 3] * rstd * gp.w);
    }
  }
  if (outx) {
#pragma unroll
    for (int i = 0; i < 4; ++i) {
      float4 v; v.x = x[4 * i]; v.y = x[4 * i + 1]; v.z = x[4 * i + 2]; v.w = x[4 * i + 3];
      *(float4*)(outx + (i * 64 + lane) * 4) = v;
    }
  }
  if (outh) {
    float ss = 0.f;
#pragma unroll
    for (int i = 0; i < 16; ++i) ss += x[i] * x[i];
    ss = wsum(ss);
    const float rstd = rsqrtf(ss * (1.f / DM) + EPS);
#pragma unroll
    for (int i = 0; i < 4; ++i) {
      const int idx = (i * 64 + lane) * 4;
      const float4 g = *(const float4*)(gpre + idx);
      const float4 s1 = *(const float4*)(sc + idx);
      const float4 s0 = *(const float4*)(sh + idx);
      const float h0 = x[4 * i] * rstd * g.x * (1.f + s1.x) + s0.x;
      const float h1 = x[4 * i + 1] * rstd * g.y * (1.f + s1.y) + s0.y;
      const float h2 = x[4 * i + 2] * rstd * g.z * (1.f + s1.z) + s0.z;
      const float h3 = x[4 * i + 3] * rstd * g.w * (1.f + s1.w) + s0.w;
      uint2 o; o.x = pk2(h0, h1); o.y = pk2(h2, h3);
      *(uint2*)(outh + (size_t)r * DM + idx) = o;
    }
  }
}

DI void phase_rows(const Params& p, int l, int mode) {
  const int tid = tid_l(), lane = tid & 63;
  const int gw = blockIdx.x * 4 + (tid >> 6), nw = gridDim.x * 4;
  const float* mod = (const float*)(p.ws + WS_MOD);
  float* yout = p.out + O_Y;
  for (int r = gw; r < T; r += nw) {
    const int g = grp_of(r);
    const float* ml = mod + (size_t)(l * 5 + g) * 6144;
    if (mode == 0) {
      row_resnorm(r, xin_row(p, r), nullptr, nullptr, nullptr, p.in[11] + l * DM, ml + 1024, ml, nullptr,
                  (u16*)(p.ws + WS_H), lane);
    } else if (mode == 1) {
      const float* xr = (l == 0) ? xin_row(p, r) : yout + (size_t)r * DM;
      row_resnorm(r, xr, (const u16*)(p.ws + WS_MO), p.in[12] + l * DM, ml + 2048, p.in[13] + l * DM, ml + 4096,
                  ml + 3072, yout + (size_t)r * DM, (u16*)(p.ws + WS_H), lane);
    } else {
      const float* mn = mod + (size_t)((l + 1) * 5 + g) * 6144;
      const bool last = (l == DEPTH - 1);
      row_resnorm(r, yout + (size_t)r * DM, (const u16*)(p.ws + WS_M), p.in[14] + l * DM, ml + 5120,
                  last ? nullptr : p.in[11] + (l + 1) * DM, last ? nullptr : mn + 1024, last ? nullptr : mn,
                  yout + (size_t)r * DM, last ? nullptr : (u16*)(p.ws + WS_H), lane);
    }
  }
}

DI void phase_post_proj(const Params& p, int l) {
  const int tid = tid_l(), lane = tid & 63;
  const int gw = blockIdx.x * 4 + (tid >> 6), nw = gridDim.x * 4;
  u16* P = (u16*)(p.ws + WS_P);
  u16* ckvn = (u16*)(p.ws + WS_CKVN);
  u16* xcv = (u16*)(p.ws + WS_XCV);
  const float* gq = p.in[17] + l * 384;
  const float* gkv = p.in[19] + l * 256;
  const float* wc = p.in[22] + l * 4 * 512;
  const float* bc = p.in[23] + l * 512;
  for (int r = gw; r < TC; r += nw) {
    if (r < T) {
      u16* pr = P + (size_t)r * PP;
      {
        float v[6];
        float ss = 0.f;
#pragma unroll
        for (int i = 0; i < 6; ++i) { v[i] = bf2f(pr[C_CQ + i * 64 + lane]); ss += v[i] * v[i]; }
        ss = wsum(ss);
        const float rstd = rsqrtf(ss * (1.f / 384.f) + EPS);
#pragma unroll
        for (int i = 0; i < 6; ++i) pr[C_CQ + i * 64 + lane] = f2bf(v[i] * rstd * gq[i * 64 + lane]);
      }
      {
        float v[4];
        float ss = 0.f;
#pragma unroll
        for (int i = 0; i < 4; ++i) { v[i] = bf2f(pr[C_CKV + i * 64 + lane]); ss += v[i] * v[i]; }
        ss = wsum(ss);
        const float rstd = rsqrtf(ss * (1.f / 256.f) + EPS);
#pragma unroll
        for (int i = 0; i < 4; ++i) {
          const float o = v[i] * rstd * gkv[i * 64 + lane];
          ckvn[(size_t)r * 256 + i * 64 + lane] = f2bf(o);
          if (r < NCTX) {
            const int b = r >> 8, s = r & 255;
            p.out[O_CKV + ((size_t)(b * 4 + l) * 256 + s) * 256 + i * 64 + lane] = o;
          }
        }
      }
      {
        int pos, L;
        if (r < NCTX) { pos = r & 255; L = 256; } else { pos = (r - NCTX) & 4095; L = 4096; }
        float acc[8];
        const float4 b0 = *(const float4*)(bc + lane * 8), b1 = *(const float4*)(bc + lane * 8 + 4);
        acc[0] = b0.x; acc[1] = b0.y; acc[2] = b0.z; acc[3] = b0.w; acc[4] = b1.x; acc[5] = b1.y; acc[6] = b1.z; acc[7] = b1.w;
#pragma unroll
        for (int j = 0; j < 4; ++j) {
          const int pp = pos + j - 1;
          if (pp >= 0 && pp < L) {
            const uint4 u = *(const uint4*)(P + (size_t)(r + j - 1) * PP + C_XC + lane * 8);
            const float4 w0 = *(const float4*)(wc + j * 512 + lane * 8), w1 = *(const float4*)(wc + j * 512 + lane * 8 + 4);
            acc[0] += w0.x * lo_bf(u.x); acc[1] += w0.y * hi_bf(u.x); acc[2] += w0.z * lo_bf(u.y); acc[3] += w0.w * hi_bf(u.y);
            acc[4] += w1.x * lo_bf(u.z); acc[5] += w1.y * hi_bf(u.z); acc[6] += w1.z * lo_bf(u.w); acc[7] += w1.w * hi_bf(u.w);
          }
        }
        uint4 o; o.x = pk2(acc[0], acc[1]); o.y = pk2(acc[2], acc[3]); o.z = pk2(acc[4], acc[5]); o.w = pk2(acc[6], acc[7]);
        *(uint4*)(xcv + (size_t)r * 512 + lane * 8) = o;
      }
    } else {
      const int cr = r - T, b = cr >> 9, pp = cr & 511;
      const float* src = p.in[4] + ((size_t)(b * 4 + l) * 512 + pp) * 256;
#pragma unroll
      for (int i = 0; i < 4; ++i) ckvn[(size_t)r * 256 + i * 64 + lane] = f2bf(src[i * 64 + lane]);
    }
  }
}

template <int HALF>
DI void rope4(float& v0, float& v1, float& v2, float& v3, int cc  , int t0, const float2* tab) {
  const float p0 = __shfl_xor(v0, HALF, 64), p1 = __shfl_xor(v1, HALF, 64), p2 = __shfl_xor(v2, HALF, 64), p3 = __shfl_xor(v3, HALF, 64);
  const int blk = (cc / (2 * HALF)) & 1;
  const int jj = cc % (2 * HALF), j = jj % HALF;
  const float sgn = jj < HALF ? -1.f : 1.f;
  const float inv = __builtin_amdgcn_exp2f(-(float)j * (13.287712379549449f / (float)HALF));
  float vv[4] = {v0, v1, v2, v3}, pp[4] = {p0, p1, p2, p3};
#pragma unroll
  for (int e = 0; e < 4; ++e) {
    const int t = t0 + e;
    const int pos = blk ? (t & 63) : (t >> 6);
    const float rev = ((float)pos * inv) * 0.15915494309189535f;
    vv[e] = vv[e] * __builtin_amdgcn_cosf(rev) + sgn * pp[e] * __builtin_amdgcn_sinf(rev);
  }
  v0 = vv[0]; v1 = vv[1]; v2 = vv[2]; v3 = vv[3];
}

template <int NKS>
struct AttnState {
  bf16x8 bq[NKS];
  f32x16 o0, o1;
  float m, lsum;
};

template <int NKS>
DI void attn_init(AttnState<NKS>& st, const u16* qptr  , int has_sink, float sink_l2e) {
  const int h = (tid_l() & 63) >> 5;
#pragma unroll
  for (int ks = 0; ks < NKS; ++ks) st.bq[ks] = *(const bf16x8*)(qptr + ks * 16 + h * 8);
#pragma unroll
  for (int e = 0; e < 16; ++e) { st.o0[e] = 0.f; st.o1[e] = 0.f; }
  st.m = has_sink ? sink_l2e : -1e30f;
  st.lsum = 0.f;
}

template <int NKS, bool MASKED>
DI void attn_core(AttnState<NKS>& st, const bf16x8 (&ak)[NKS], uint2 v00l, uint2 v00h, uint2 v01l, uint2 v01h, uint2 v10l,
                  uint2 v10h, uint2 v11l, uint2 v11h, float scale_l2e, int qpos, int k0, int h) {
  f32x16 s;
#pragma unroll
  for (int e = 0; e < 16; ++e) s[e] = 0.f;
#pragma unroll
  for (int ks = 0; ks < NKS; ++ks) s = MFMA32(ak[ks], st.bq[ks], s);
  float bm = -3e38f;
#pragma unroll
  for (int e = 0; e < 16; ++e) {
    if (MASKED) {
      const int kpos = k0 + (e & 3) + 8 * (e >> 2) + 4 * h;
      const int d = qpos - kpos;
      if (d > 128 || d < -128) s[e] = -1e30f;
    }
    bm = fmaxf(bm, s[e]);
  }
  bm = fmaxf(bm, __shfl_xor(bm, 32, 64));
  const float mn = fmaxf(st.m, bm * scale_l2e);
  if (__any(mn > st.m + 8.f)) {
    const float alpha = __builtin_amdgcn_exp2f(st.m - mn);
    st.m = mn;
    st.lsum *= alpha;
#pragma unroll
    for (int e = 0; e < 16; ++e) { st.o0[e] *= alpha; st.o1[e] *= alpha; }
  }
  const float mref = st.m;
  float ps = 0.f;
#pragma unroll
  for (int e = 0; e < 16; ++e) { s[e] = __builtin_amdgcn_exp2f(__builtin_fmaf(s[e], scale_l2e, -mref)); ps += s[e]; }
  st.lsum += ps;
  uint4 pq0, pq1;
  pq0.x = pk2(s[0], s[1]); pq0.y = pk2(s[2], s[3]); pq0.z = pk2(s[4], s[5]); pq0.w = pk2(s[6], s[7]);
  pq1.x = pk2(s[8], s[9]); pq1.y = pk2(s[10], s[11]); pq1.z = pk2(s[12], s[13]); pq1.w = pk2(s[14], s[15]);
  const bf16x8 pb0 = __builtin_bit_cast(bf16x8, pq0), pb1 = __builtin_bit_cast(bf16x8, pq1);
  uint4 a;
  a.x = v00l.x; a.y = v00l.y; a.z = v00h.x; a.w = v00h.y;
  st.o0 = MFMA32(__builtin_bit_cast(bf16x8, a), pb0, st.o0);
  a.x = v01l.x; a.y = v01l.y; a.z = v01h.x; a.w = v01h.y;
  st.o0 = MFMA32(__builtin_bit_cast(bf16x8, a), pb1, st.o0);
  a.x = v10l.x; a.y = v10l.y; a.z = v10h.x; a.w = v10h.y;
  st.o1 = MFMA32(__builtin_bit_cast(bf16x8, a), pb0, st.o1);
  a.x = v11l.x; a.y = v11l.y; a.z = v11h.x; a.w = v11h.y;
  st.o1 = MFMA32(__builtin_bit_cast(bf16x8, a), pb1, st.o1);
}

template <int NKS, bool MASKED>
DI void attn_seg(AttnState<NKS>& st, const u16* __restrict__ K, int kst, const u16* __restrict__ Kr, int krst,
                 const u16* __restrict__ Vt, int vst, int kbeg, int kend, float scale_l2e, int qpos) {
  const int lane = tid_l() & 63, r = lane & 31, h = lane >> 5;
  for (int k0 = kbeg; k0 < kend; k0 += 32) {
    const u16* kp = K + (size_t)(k0 + r) * kst + h * 8;
    bf16x8 ak[NKS];
#pragma unroll
    for (int ks = 0; ks < 4; ++ks) ak[ks] = *(const bf16x8*)(kp + ks * 16);
    if (NKS == 6) {
      const u16* krp = Kr + (size_t)(k0 + r) * krst + h * 8;
      ak[NKS - 2] = *(const bf16x8*)(krp);
      ak[NKS - 1] = *(const bf16x8*)(krp + 16);
    }
    const u16* vp = Vt + (size_t)r * vst + k0 + 4 * h;
    const u16* vp1 = vp + (size_t)32 * vst;
    const uint2 v00l = *(const uint2*)(vp), v00h = *(const uint2*)(vp + 8);
    const uint2 v01l = *(const uint2*)(vp + 16), v01h = *(const uint2*)(vp + 24);
    const uint2 v10l = *(const uint2*)(vp1), v10h = *(const uint2*)(vp1 + 8);
    const uint2 v11l = *(const uint2*)(vp1 + 16), v11h = *(const uint2*)(vp1 + 24);
    attn_core<NKS, MASKED>(st, ak, v00l, v00h, v01l, v01h, v10l, v10h, v11l, v11h, scale_l2e, qpos, k0, h);
  }
}

constexpr int MK_P = 104, MV_P = 72;
DI void mla_latent_item(AttnState<6>& st, const u16* kn_lat, const u16* kr_lat, const u16* kn_c, const u16* kr_c,
                        const u16* vt, float scale_l2e, u16* smem) {
  const int tid = tid_l(), lane = tid & 63, r = lane & 31, h = lane >> 5;
  u16* sK = smem;
  u16* sV = smem + 2 * 64 * MK_P;
  const int c0 = tid, c1 = tid + 256;
  const int kr0 = c0 >> 3, kc0 = (c0 & 7) * 8, kr1 = c1 >> 3, kc1 = (c1 & 7) * 8;
  const int rr = tid >> 2, rc = (tid & 3) * 8;
  uint4 g0, g1, g2, g3, g4;
  auto gl = [&](int sidx) {
    const bool lat = sidx < 64;
    const int key0 = lat ? sidx * 64 : (sidx - 64) * 64;
    const u16* kb = (lat ? kn_lat : kn_c) + (size_t)key0 * 512;
    g0 = *(const uint4*)(kb + (size_t)kr0 * 512 + kc0);
    g1 = *(const uint4*)(kb + (size_t)kr1 * 512 + kc1);
    g2 = lat ? *(const uint4*)(kr_lat + (size_t)(key0 + rr) * PP + rc) : *(const uint4*)(kr_c + (size_t)(key0 + rr) * 32 + rc);
    const u16* vb = vt + (lat ? key0 : 4096 + key0);
    g3 = *(const uint4*)(vb + (size_t)kr0 * 4608 + kc0);
    g4 = *(const uint4*)(vb + (size_t)kr1 * 4608 + kc1);
  };
  auto ss = [&](int buf) {
    *(uint4*)(sK + (buf * 64 + kr0) * MK_P + kc0) = g0;
    *(uint4*)(sK + (buf * 64 + kr1) * MK_P + kc1) = g1;
    *(uint4*)(sK + (buf * 64 + rr) * MK_P + 64 + rc) = g2;
    *(uint4*)(sV + (buf * 64 + kr0) * MV_P + kc0) = g3;
    *(uint4*)(sV + (buf * 64 + kr1) * MV_P + kc1) = g4;
  };
  gl(0);
  ss(0);
  __syncthreads();
  const int NST = 72;
  for (int sidx = 0; sidx < NST; ++sidx) {
    const int buf = sidx & 1;
    if (sidx + 1 < NST) gl(sidx + 1);
#pragma unroll
    for (int sub = 0; sub < 2; ++sub) {
      const u16* kp = sK + (buf * 64 + sub * 32 + r) * MK_P + h * 8;
      bf16x8 ak[6];
#pragma unroll
      for (int ks = 0; ks < 6; ++ks) ak[ks] = *(const bf16x8*)(kp + ks * 16);
      const u16* vp = sV + (buf * 64 + r) * MV_P + sub * 32 + 4 * h;
      const u16* vp1 = vp + 32 * MV_P;
      const uint2 v00l = *(const uint2*)(vp), v00h = *(const uint2*)(vp + 8);
      const uint2 v01l = *(const uint2*)(vp + 16), v01h = *(const uint2*)(vp + 24);
      const uint2 v10l = *(const uint2*)(vp1), v10h = *(const uint2*)(vp1 + 8);
      const uint2 v11l = *(const uint2*)(vp1 + 16), v11h = *(const uint2*)(vp1 + 24);
      attn_core<6, false>(st, ak, v00l, v00h, v01l, v01h, v10l, v10h, v11l, v11h, scale_l2e, 0, 0, h);
    }
    if (sidx + 1 < NST) ss(buf ^ 1);
    __syncthreads();
  }
}

constexpr int GK_P = 72, GV_P = 40;
template <bool MASKA>
DI void gqa_staged(AttnState<4>& st, const u16* KA, int kstA, const u16* VA, int vstA, int keyA0, int nA, const u16* KB,
                   int kstB, const u16* VB, int vstB, int nB, float scale_l2e, int qpos, u16* smem) {
  const int tid = tid_l(), lane = tid & 63, r = lane & 31, h = lane >> 5;
  u16* sK = smem;
  u16* sV = smem + 2 * 32 * GK_P;
  const int krow = tid >> 3, kch = (tid & 7) * 8;
  const int vrow = tid >> 2, vch = (tid & 3) * 8;
  const int NST = nA + nB;
  uint4 g0, g1;
  auto gl = [&](int sidx) {
    if (sidx < nA) {
      const int key = keyA0 + sidx * 32;
      g0 = *(const uint4*)(KA + (size_t)(key + krow) * kstA + kch);
      g1 = *(const uint4*)(VA + (size_t)vrow * vstA + key + vch);
    } else {
      const int key = (sidx - nA) * 32;
      g0 = *(const uint4*)(KB + (size_t)(key + krow) * kstB + kch);
      g1 = *(const uint4*)(VB + (size_t)vrow * vstB + key + vch);
    }
  };
  auto ss = [&](int buf) {
    *(uint4*)(sK + (buf * 32 + krow) * GK_P + kch) = g0;
    *(uint4*)(sV + (buf * 64 + vrow) * GV_P + vch) = g1;
  };
  gl(0);
  ss(0);
  __syncthreads();
  for (int sidx = 0; sidx < NST; ++sidx) {
    const int buf = sidx & 1;
    if (sidx + 1 < NST) gl(sidx + 1);
    const u16* kp = sK + (buf * 32 + r) * GK_P + h * 8;
    bf16x8 ak[4];
#pragma unroll
    for (int ks = 0; ks < 4; ++ks) ak[ks] = *(const bf16x8*)(kp + ks * 16);
    const u16* vp = sV + (buf * 64 + r) * GV_P + 4 * h;
    const u16* vp1 = vp + 32 * GV_P;
    const uint2 v00l = *(const uint2*)(vp), v00h = *(const uint2*)(vp + 8);
    const uint2 v01l = *(const uint2*)(vp + 16), v01h = *(const uint2*)(vp + 24);
    const uint2 v10l = *(const uint2*)(vp1), v10h = *(const uint2*)(vp1 + 8);
    const uint2 v11l = *(const uint2*)(vp1 + 16), v11h = *(const uint2*)(vp1 + 24);
    if (MASKA && sidx < nA)
      attn_core<4, true>(st, ak, v00l, v00h, v01l, v01h, v10l, v10h, v11l, v11h, scale_l2e, qpos, keyA0 + sidx * 32, h);
    else
      attn_core<4, false>(st, ak, v00l, v00h, v01l, v01h, v10l, v10h, v11l, v11h, scale_l2e, 0, 0, h);
    if (sidx + 1 < NST) ss(buf ^ 1);
    __syncthreads();
  }
}

template <int NKS>
DI void attn_finish(AttnState<NKS>& st, int has_sink, float sink_l2e, u16* optr  ) {
  const int h = (threadIdx.x & 63) >> 5;
  float lt = st.lsum + __shfl_xor(st.lsum, 32, 64);
  if (has_sink) lt += __builtin_amdgcn_exp2f(sink_l2e - st.m);
  const float inv = 1.f / lt;
#pragma unroll
  for (int g = 0; g < 4; ++g) {
    uint2 a, b;
    a.x = pk2(st.o0[4 * g] * inv, st.o0[4 * g + 1] * inv); a.y = pk2(st.o0[4 * g + 2] * inv, st.o0[4 * g + 3] * inv);
    b.x = pk2(st.o1[4 * g] * inv, st.o1[4 * g + 1] * inv); b.y = pk2(st.o1[4 * g + 2] * inv, st.o1[4 * g + 3] * inv);
    *(uint2*)(optr + 8 * g + 4 * h) = a;
    *(uint2*)(optr + 32 + 8 * g + 4 * h) = b;
  }
}

struct ScanGeo {
  int rbase, sidx, cg, tc, CLS, NS;
};
DI ScanGeo scan_geo(int it) {
  ScanGeo g;
  if (it < 256) { const int b = it >> 6; g.rbase = NCTX + b * 4096; g.sidx = 16 + b; g.cg = (it >> 3) & 7; g.tc = it & 7; g.CLS = 128; g.NS = 32; }
  else { const int j = it - 256, b = j >> 3; g.rbase = b * 256; g.sidx = b; g.cg = j & 7; g.tc = 0; g.CLS = 64; g.NS = 4; }
  return g;
}
DI void scan_coef(float rr, float ig, float x, float cA, float& a, float& u) {
  a = __expf(cA * rr);
  u = __builtin_sqrtf(fmaxf(1.f - a * a, 0.f)) * ig * x;
}
DI void scan_sum_item(const Params& p, int l, int it) {
  const ScanGeo g = scan_geo(it);
  const int tid = tid_l(), sc = tid >> 6, chl = tid & 63, ch = g.cg * 64 + chl;
  const u16* G = (const u16*)(p.ws + WS_G);
  const u16* xcv = (const u16*)(p.ws + WS_XCV);
  float* SUM = (float*)(p.ws + WS_SUM);
  const float cAf = -8.f * log1pf(__expf(-p.in[24][(l * 2 + 0) * 512 + ch]));
  const float cAb = -8.f * log1pf(__expf(-p.in[24][(l * 2 + 1) * 512 + ch]));
  const int slot = g.tc * 4 + sc;
  const size_t row0 = (size_t)g.rbase + (size_t)slot * g.CLS;
  const u16* gp = G + row0 * 2048 + ch;
  const u16* xp = xcv + row0 * 512 + ch;
  float Pf = 1.f, Hf = 0.f, Pb = 1.f, Hb = 0.f;
#pragma unroll 8
  for (int s = 0; s < g.CLS; ++s) {
    const float raf = bf2f(gp[(size_t)s * 2048]), rif = bf2f(gp[(size_t)s * 2048 + 512]);
    const float rab = bf2f(gp[(size_t)s * 2048 + 1024]), rib = bf2f(gp[(size_t)s * 2048 + 1536]);
    const float x = bf2f(xp[(size_t)s * 512]);
    float a, u;
    scan_coef(raf, rif, x, cAf, a, u);
    Hf = a * Hf + u; Pf *= a;
    scan_coef(rab, rib, x, cAb, a, u);
    Hb += Pb * u; Pb *= a;
  }
  float* so = SUM + ((size_t)(g.sidx * 8 + g.cg) * 32 + slot) * 256 + chl;
  so[0] = Pf; so[64] = Hf; so[128] = Pb; so[192] = Hb;
}
DI void scan_apply_item(const Params& p, int l, int it) {
  const ScanGeo g = scan_geo(it);
  const int tid = tid_l(), sc = tid >> 6, chl = tid & 63, ch = g.cg * 64 + chl;
  const u16* G = (const u16*)(p.ws + WS_G);
  const u16* xcv = (const u16*)(p.ws + WS_XCV);
  const u16* P = (const u16*)(p.ws + WS_P);
  u16* yc = (u16*)(p.ws + WS_YC);
  const float* SUM = (const float*)(p.ws + WS_SUM) + (size_t)(g.sidx * 8 + g.cg) * 32 * 256 + chl;
  const float cAf = -8.f * log1pf(__expf(-p.in[24][(l * 2 + 0) * 512 + ch]));
  const float cAb = -8.f * log1pf(__expf(-p.in[24][(l * 2 + 1) * 512 + ch]));
  const int slot = g.tc * 4 + sc;
  const bool lat = g.sidx >= 16;
  float hf = lat ? p.in[6][((size_t)((g.sidx - 16) * 4 + l) * 2 + 0) * 512 + ch] : 0.f;
  float hb = lat ? p.in[6][((size_t)((g.sidx - 16) * 4 + l) * 2 + 1) * 512 + ch] : 0.f;
  for (int s = 0; s < slot; ++s) hf = SUM[(size_t)s * 256] * hf + SUM[(size_t)s * 256 + 64];
  for (int s = g.NS - 1; s > slot; --s) hb = SUM[(size_t)s * 256 + 128] * hb + SUM[(size_t)s * 256 + 192];
  const size_t row0 = (size_t)g.rbase + (size_t)slot * g.CLS;
  const u16* gp = G + row0 * 2048 + ch;
  const u16* xp = xcv + row0 * 512 + ch;
  u16* yp = yc + row0 * 512 + ch;
  const u16* gcp = P + row0 * PP + C_GC + ch;
#pragma unroll 8
  for (int s = 0; s < g.CLS; ++s) {
    const float raf = bf2f(gp[(size_t)s * 2048]), rif = bf2f(gp[(size_t)s * 2048 + 512]);
    const float x = bf2f(xp[(size_t)s * 512]);
    float a, u;
    scan_coef(raf, rif, x, cAf, a, u);
    hf = a * hf + u;
    yp[(size_t)s * 512] = f2bf(hf);
  }
#pragma unroll 8
  for (int s = g.CLS - 1; s >= 0; --s) {
    const float rab = bf2f(gp[(size_t)s * 2048 + 1024]), rib = bf2f(gp[(size_t)s * 2048 + 1536]);
    const float x = bf2f(xp[(size_t)s * 512]);
    float a, u;
    scan_coef(rab, rib, x, cAb, a, u);
    hb = a * hb + u;
    const float hfv = bf2f(yp[(size_t)s * 512]);
    const float gcv = bf2f(gcp[(size_t)s * PP]);
    const float ge = 0.5f * gcv * (1.f + tanhf(0.7978845608028654f * (gcv + 0.044715f * gcv * gcv * gcv)));
    yp[(size_t)s * 512] = f2bf(ge * (hfv + hb));
  }
  if (!lat) {
    float* st = p.out + O_ST + (size_t)(g.sidx * 4 + l) * 1024;
    if (slot == g.NS - 1) st[ch] = hf;
    if (slot == 0) st[512 + ch] = hb;
  }
}

#define XB_TMO      128
#define XB_XCNT(j)  (256  + 64 * (j))
#define XB_XSUB(j)  (1280 + 64 * (j))
#define XB_XGEN(j)  (2304 + 64 * (j))
#define XB_TOP      3328
#define XB_TOPGEN   3392
#define XCD_BAR_WORDS 3456
#define XB_SPIN_CAP (1u << 18)
#define LAS __attribute__((address_space(3)))

__device__ __forceinline__ unsigned xb_ld(unsigned* p)              { return __hip_atomic_load(p, __ATOMIC_RELAXED, __HIP_MEMORY_SCOPE_AGENT); }
__device__ __forceinline__ unsigned xb_add(unsigned* p, unsigned v) { return __hip_atomic_fetch_add(p, v, __ATOMIC_RELAXED, __HIP_MEMORY_SCOPE_AGENT); }
__device__ __forceinline__ unsigned xb_xcc_id() { return (unsigned)__builtin_amdgcn_s_getreg((3 << 11) | 20) & 0xFu; }
#define XB_SPIN(cond, bar) do { unsigned _sp = 0; while (cond) { __builtin_amdgcn_s_sleep(1); \
    if ((++_sp & 255u) == 0u) { if (xb_ld(&(bar)[XB_TMO])) break; if (_sp > XB_SPIN_CAP) { atomicAdd(&(bar)[XB_TMO], 1u); break; } } } } while (0)

struct XcdBarrier {
    unsigned* bar; unsigned x;
    volatile LAS unsigned* st;
};

__device__ __forceinline__ XcdBarrier xcd_barrier_post(unsigned* bar, volatile LAS unsigned* st) {
    XcdBarrier b; b.bar = bar; b.x = xb_xcc_id(); b.st = st;
    if (threadIdx.x == 0) (void)xb_add(&bar[XB_XCNT(b.x)], 1u);
    return b;
}
__device__ __forceinline__ void xcd_barrier_complete(unsigned* bar, unsigned x, unsigned& nloc, unsigned& nx) {
    const unsigned G = gridDim.x * gridDim.y * gridDim.z;
    unsigned sum, cnt, mine, sp = 0u;
    for (;;) {
        sum = 0u; cnt = 0u; mine = 0u;
#pragma unroll
        for (unsigned j = 0; j < 16; ++j) { const unsigned c = xb_ld(&bar[XB_XCNT(j)]); sum += c; cnt += (c > 0u) ? 1u : 0u; mine = (j == x) ? c : mine; }
        if (sum == G) break;
        __builtin_amdgcn_s_sleep(1);
        if ((++sp & 255u) == 0u) { if (xb_ld(&bar[XB_TMO])) break; if (sp > XB_SPIN_CAP) { atomicAdd(&bar[XB_TMO], 1u); break; } }
    }
    nloc = mine > 0u ? mine : 1u; nx = cnt > 0u ? cnt : 1u;
}

__device__ __forceinline__ void xcd_barrier(const XcdBarrier& b) {
    asm volatile("s_waitcnt vmcnt(0)" ::: "memory");
    __syncthreads();
    if (threadIdx.x == 0) {
        unsigned* bar = b.bar;
        __builtin_amdgcn_s_waitcnt(0);
        unsigned nloc = b.st[0], nx = b.st[1];
        if (nloc == 0u) { xcd_barrier_complete(bar, b.x, nloc, nx); b.st[0] = nloc; b.st[1] = nx; }
        const unsigned old = xb_add(&bar[XB_XSUB(b.x)], 1u);
        const unsigned gen = old / nloc;
        if (old + 1u == (gen + 1u) * nloc) {
            __builtin_amdgcn_fence(__ATOMIC_RELEASE, "agent");
            asm volatile("s_waitcnt vmcnt(0)" ::: "memory");
            const unsigned og = xb_add(&bar[XB_TOP], 1u);
            const unsigned tg = og / nx;
            if (og + 1u == (tg + 1u) * nx) xb_add(&bar[XB_TOPGEN], 1u);
            else XB_SPIN(xb_ld(&bar[XB_TOPGEN]) == tg, bar);
            __builtin_amdgcn_fence(__ATOMIC_ACQUIRE, "agent");
            xb_add(&bar[XB_XGEN(b.x)], 1u);
            asm volatile("s_waitcnt vmcnt(0)" ::: "memory");
        } else {
            XB_SPIN(xb_ld(&bar[XB_XGEN(b.x)]) == gen, bar);
            __builtin_amdgcn_fence(__ATOMIC_ACQUIRE, "agent");
            asm volatile("s_waitcnt vmcnt(0)" ::: "memory");
        }
    }
    __syncthreads();
}


#ifndef DBG_STOP
#define DBG_STOP 0
#define DBG_L 0
#endif
DI void dbg_dump(const Params& p, const u16* buf, size_t pitch, int ncols, int nrows, float mul, bool accumulate) {
  const size_t n = (size_t)T * 1024;
  for (size_t i = (size_t)blockIdx.x * 256 + threadIdx.x; i < n; i += (size_t)gridDim.x * 256) {
    const int r = (int)(i >> 10), c = (int)(i & 1023);
    float v = 0.f;
    if (r < nrows)
      for (int cc = c; cc < ncols; cc += 1024) v += bf2f(buf[(size_t)r * pitch + cc]);
    v *= mul;
    if (accumulate) v += p.out[O_Y + i];
    p.out[O_Y + i] = v;
  }
}
DI unsigned dbg_fold(const u16* buf, size_t pitch, int ncols, int r, int c5) {
  unsigned x = 0;
  if (buf)
    for (int cc = c5; cc < ncols; cc += 512) x ^= buf[(size_t)r * pitch + cc];
  return x;
}
DI void dbg_xor(const Params& p, const u16* b0, size_t p0, int n0, const u16* b1 = nullptr, size_t p1 = 0, int n1 = 0,
                const u16* b2 = nullptr, size_t p2 = 0, int n2 = 0, const u16* b3 = nullptr, size_t p3 = 0, int n3 = 0) {
  const size_t n = (size_t)T * 1024;
  for (size_t i = (size_t)blockIdx.x * 256 + threadIdx.x; i < n; i += (size_t)gridDim.x * 256) {
    const int r = (int)(i >> 10), c = (int)(i & 1023), c5 = c & 511;
    unsigned x = dbg_fold(b0, p0, n0, r, c5) ^ dbg_fold(b1, p1, n1, r, c5) ^ dbg_fold(b2, p2, n2, r, c5) ^ dbg_fold(b3, p3, n3, r, c5);
    p.out[O_Y + i] = (float)(c < 512 ? (x & 0xffu) : (x >> 8));
  }
}
#define DBG_AT(n, ...) do { if (DBG_STOP == (n) && l == DBG_L) { __VA_ARGS__; return; } } while (0)

__global__ void __launch_bounds__(256, 2) fwd_megakernel(Params p) {
  cg::grid_group grid = cg::this_grid();
  __shared__ __attribute__((aligned(16))) u16 smem[SMEM_BYTES / 2];
  __shared__ int s_item;
  __shared__ uint4 xb_words;
  if (threadIdx.x == 0) xb_words = make_uint4(0u, 0u, 0u, 0u);
  __syncthreads();
  XcdBarrier xb = xcd_barrier_post((unsigned*)(p.ws + WS_BAR), (volatile LAS unsigned*)&xb_words);
  grid.sync();
  const int tid = threadIdx.x, lane = tid & 63, wave = tid >> 6;
  const int NB = gridDim.x;
  char* ws = p.ws;
  float* mod = (float*)(ws + WS_MOD);
  const float2* tab16 = (const float2*)(ws + WS_TAB16);
  const float2* tab8 = (const float2*)(ws + WS_TAB8);
  u16* wt = (u16*)(ws + WS_WT);
  u16* Hb = (u16*)(ws + WS_H);
  u16* P = (u16*)(ws + WS_P);
  u16* Gt = (u16*)(ws + WS_G);
  u16* ckvn = (u16*)(ws + WS_CKVN);
  u16* xcv = (u16*)(ws + WS_XCV);
  u16* qb = (u16*)(ws + WS_QB);
  u16* kn = (u16*)(ws + WS_KN);
  u16* vml = (u16*)(ws + WS_VML);
  u16* vmc = (u16*)(ws + WS_VMC);
  u16* vgl = (u16*)(ws + WS_VGL);
  u16* vgc = (u16*)(ws + WS_VGC);
  u16* ck = (u16*)(ws + WS_CK);
  u16* ckr = (u16*)(ws + WS_CKR);
  int* ctr = (int*)(ws + WS_CTR);

  if (PHASE_MASK & 1)
  {
    float* ssil = (float*)smem;
    float* sred = ssil + 5 * 1024;
    for (int i = tid; i < 5 * 1024; i += 256) {
      const int g = i >> 10, k = i & 1023;
      const float cv = g == 0 ? p.in[8][k] : p.in[7][(g - 1) * 1024 + k];
      ssil[i] = cv / (1.f + __expf(-cv));
    }
    __syncthreads();
    for (int it = blockIdx.x; it < 4 * 96; it += NB) {
      const int l = it / 96, cc = it % 96;
      const int col = cc * 64 + lane;
      const float* w = p.in[9] + ((size_t)l * 1024 + wave * 256) * 6144 + col;
      const float* sv = ssil + wave * 256;
      float a0 = 0.f, a1 = 0.f, a2 = 0.f, a3 = 0.f, a4 = 0.f;
#pragma unroll 16
      for (int kk = 0; kk < 256; ++kk) {
        const float wv = __builtin_nontemporal_load(w + (size_t)kk * 6144);
        a0 += sv[kk] * wv; a1 += sv[1024 + kk] * wv; a2 += sv[2048 + kk] * wv; a3 += sv[3072 + kk] * wv; a4 += sv[4096 + kk] * wv;
      }
      sred[(wave * 5 + 0) * 64 + lane] = a0; sred[(wave * 5 + 1) * 64 + lane] = a1; sred[(wave * 5 + 2) * 64 + lane] = a2;
      sred[(wave * 5 + 3) * 64 + lane] = a3; sred[(wave * 5 + 4) * 64 + lane] = a4;
      __syncthreads();
      for (int i = tid; i < 320; i += 256) {
        const int g = i >> 6, cl = i & 63;
        const float v = p.in[10][l * 6144 + cc * 64 + cl] + sred[(0 * 5 + g) * 64 + cl] + sred[(1 * 5 + g) * 64 + cl] +
                        sred[(2 * 5 + g) * 64 + cl] + sred[(3 * 5 + g) * 64 + cl];
        mod[(size_t)(l * 5 + g) * 6144 + cc * 64 + cl] = v;
      }
      __syncthreads();
    }
    __syncthreads();
    const int gt = blockIdx.x * 256 + tid, ngt = NB * 256;
    for (int i = gt; i < 16 * 512 * 128 / 2; i += ngt) {
      const float2 v = *(const float2*)(p.in[2] + (size_t)i * 2);
      ((unsigned*)ck)[i] = pk2(v.x, v.y);
    }
    for (int i = gt; i < 16 * 512 * 32 / 2; i += ngt) {
      const float2 v = *(const float2*)(p.in[5] + (size_t)i * 2);
      ((unsigned*)ckr)[i] = pk2(v.x, v.y);
    }
    {
      float* sT = (float*)smem;
      u16* vct = (u16*)(ws + WS_VCT);
      for (int it = blockIdx.x; it < 16 * 2 * 8; it += NB) {
        const int pc = it & 7, kvh = (it >> 3) & 1, bl = it >> 4;
        __syncthreads();
        for (int i = tid; i < 64 * 64; i += 256) {
          const int pp = i >> 6, d = i & 63;
          sT[d * 65 + pp] = p.in[3][((size_t)bl * 512 + pc * 64 + pp) * 128 + kvh * 64 + d];
        }
        __syncthreads();
        for (int i = tid; i < 64 * 32; i += 256) {
          const int d = i >> 5, p2 = (i & 31) * 2;
          *(unsigned*)(vct + ((size_t)(bl * 2 + kvh) * 64 + d) * 512 + pc * 64 + p2) = pk2(sT[d * 65 + p2], sT[d * 65 + p2 + 1]);
        }
      }
      __syncthreads();
    }
    transpose_layer(p, 0, (float*)smem);
  }
  GSYNC();
  phase_rows(p, 0, 0);
  GSYNC();

#pragma unroll 1
  for (int l = 0; l < DEPTH; ++l) {
    DBG_AT(1, dbg_xor(p, Hb, 1024, 1024));
  if (PHASE_MASK & 2)
    {
      const int NT = 20;
      GCarry carry;
      carry.xa0 = carry.xa1 = carry.xa2 = carry.xa3 = carry.xb0 = carry.xb1 = carry.xb2 = carry.xb3 = carry.ya0 = carry.ya1 = carry.ya2 = carry.ya3 = carry.yb0 = carry.yb1 = carry.yb2 = carry.yb3 = make_uint4(0u, 0u, 0u, 0u);
      for (int rep = 0; rep < REP_GEMM; ++rep)
      for (int t = blockIdx.x; t < 160 * NT; t += NB) {
        const int mt = (t & 7) + 8 * ((t >> 3) / NT), nt = (t >> 3) % NT;
        const int m0 = mt * 128, n0 = nt * 128;
        f32x16 acc[2][2];
        zero_acc<2>(acc);
        const int nvalid = (PW - n0) < 128 ? (PW - n0) : 128;
        {
          const int tn_ = t + NB < 160 * NT ? t + NB : t;
          const int mtn = (tn_ & 7) + 8 * ((tn_ >> 3) / NT), ntn = (tn_ >> 3) % NT;
          const int nvn = (PW - ntn * 128) < 128 ? (PW - ntn * 128) : 128;
          gemm_stream(t == (int)blockIdx.x, carry, Hb + (size_t)m0 * 1024, 1024, wt + WT_IN + (size_t)n0 * 1024, 1024, nvalid,
                      Hb + (size_t)mtn * 128 * 1024, wt + WT_IN + (size_t)ntn * 128 * 1024, nvn, 1024, smem, acc);
        }
        const bool isctx = m0 < NCTX;
        gemm_epilogue<2>(acc, [&](int rr, int cc, float v0, float v1, float v2, float v3) {
          const int col = n0 + cc;
          const int ctile = n0 + (cc & ~31);
          if (ctile >= PW) return;
          const int row = m0 + rr;
          if (!isctx) {
            const int t0 = (row - NCTX) & 4095;
            if (!DBG_NOROPE) { if (ctile < C_VA) rope4<16>(v0, v1, v2, v3, col & 63, t0, tab16);
            else if (ctile == C_KR) rope4<8>(v0, v1, v2, v3, col - C_KR, t0, tab8); }
          }
          if (ctile >= C_VA && ctile < C_CQ) {
            const int c = col - C_VA, kvh = c >> 6, d = c & 63;
            uint2 o; o.x = pk2(v0, v1); o.y = pk2(v2, v3);
            if (isctx) {
              const int b = row >> 8, s = row & 255;
              *(uint2*)(vgc + ((size_t)(b * 2 + kvh) * 64 + d) * 256 + s) = o;
              float* ov = p.out + O_V + ((size_t)(b * 4 + l) * 256 + s) * 128 + c;
              ov[0] = v0; ov[128] = v1; ov[256] = v2; ov[384] = v3;
            } else {
              const int b = (row - NCTX) >> 12, tt = (row - NCTX) & 4095;
              *(uint2*)(vgl + ((size_t)(b * 2 + kvh) * 64 + d) * 4608 + tt) = o;
            }
          } else {
            u16* dst = P + (size_t)row * PP + col;
            dst[0] = f2bf(v0); dst[PP] = f2bf(v1); dst[2 * PP] = f2bf(v2); dst[3 * PP] = f2bf(v3);
            if (isctx) {
              const int b = row >> 8, s = row & 255;
              if (ctile >= C_KA && ctile < C_VA) {
                float* ok = p.out + O_K + ((size_t)(b * 4 + l) * 256 + s) * 128 + (col - C_KA);
                ok[0] = v0; ok[128] = v1; ok[256] = v2; ok[384] = v3;
              } else if (ctile == C_KR) {
                float* okr = p.out + O_KR + ((size_t)(b * 4 + l) * 256 + s) * 32 + (col - C_KR);
                okr[0] = v0; okr[32] = v1; okr[64] = v2; okr[96] = v3;
              }
            }
          }
        });
      }
    }
    GSYNC();
    DBG_AT(2, dbg_xor(p, P, PP, 640, P + 768, PP, 1696));
  if (PHASE_MASK & 4)
    phase_post_proj(p, l);
    GSYNC();
    DBG_AT(3, dbg_xor(p, P, PP, PW, ckvn, 256, 256, xcv, 512, 512));
  if (PHASE_MASK & 8)
    {
      const int NQ = 160 * 6, NKV = 176 * 8, NG = 160 * 16;
      for (int rep = 0; rep < REP_GEMM; ++rep)
      for (int t = blockIdx.x; t < NQ + NKV + NG; t += NB) {
        f32x16 acc[2][2];
        zero_acc<2>(acc);
        if (t < NQ) {
          const int mt = (t & 7) + 8 * ((t >> 3) / 6), nt = (t >> 3) % 6, m0 = mt * 128, n0 = nt * 128;
          gemm_mainloop<2>(P + (size_t)m0 * PP + C_CQ, PP, wt + WT_QUP + (size_t)n0 * 384, 384, 128, 384, smem, acc);
          const bool isctx = m0 < NCTX;
          gemm_epilogue<2>(acc, [&](int rr, int cc, float v0, float v1, float v2, float v3) {
            const int col = n0 + cc, row = m0 + rr;
            const int ctile = n0 + (cc & ~31);
            if (!isctx && (ctile % 96) == 64) rope4<8>(v0, v1, v2, v3, (col % 96) - 64, (row - NCTX) & 4095, tab8);
            u16* dst = qb + (size_t)row * 768 + col;
            dst[0] = f2bf(v0); dst[768] = f2bf(v1); dst[2 * 768] = f2bf(v2); dst[3 * 768] = f2bf(v3);
          });
        } else if (t < NQ + NKV) {
          const int tt = t - NQ, mt = (tt & 7) + 8 * (tt >> 6), nt = (tt >> 3) & 7, m0 = mt * 128, n0 = nt * 128;
          gemm_mainloop<2>(ckvn + (size_t)m0 * 256, 256, wt + WT_KV + (size_t)n0 * 256, 256, 128, 256, smem, acc);
          gemm_epilogue<2>(acc, [&](int rr, int cc, float v0, float v1, float v2, float v3) {
            const int col = n0 + cc, row = m0 + rr;
            if (n0 < 512) {
              u16* dst = kn + (size_t)row * 512 + col;
              dst[0] = f2bf(v0); dst[512] = f2bf(v1); dst[1024] = f2bf(v2); dst[1536] = f2bf(v3);
            } else {
              const int c = col - 512, hh = c >> 6, d = c & 63;
              uint2 o; o.x = pk2(v0, v1); o.y = pk2(v2, v3);
              if (row < NCTX) {
                const int b = row >> 8, s = row & 255;
                *(uint2*)(vmc + ((size_t)(b * 8 + hh) * 64 + d) * 256 + s) = o;
              } else if (row < T) {
                const int b = (row - NCTX) >> 12, tk = (row - NCTX) & 4095;
                *(uint2*)(vml + ((size_t)(b * 8 + hh) * 64 + d) * 4608 + tk) = o;
              } else {
                const int b = (row - T) >> 9, pp = (row - T) & 511;
                *(uint2*)(vml + ((size_t)(b * 8 + hh) * 64 + d) * 4608 + 4096 + pp) = o;
              }
            }
          });
        } else {
          const int tt = t - NQ - NKV, mt = (tt & 7) + 8 * (tt >> 7), nb = (tt >> 4) & 7, nt = (tt >> 3) & 1, m0 = mt * 128, n0 = nt * 128;
          gemm_mainloop<2>(xcv + (size_t)m0 * 512 + nb * 64, 512, wt + WT_G + (size_t)(nb * 256 + n0) * 64, 64, 128, 64, smem, acc);
          gemm_epilogue<2>(acc, [&](int rr, int cc, float v0, float v1, float v2, float v3) {
            const int c256 = n0 + cc, which = c256 >> 6, d = c256 & 63, ch = nb * 64 + d, row = m0 + rr;
            const int dir = which >> 1;
            const float bias = ((which & 1) ? p.in[28] : p.in[26])[(l * 2 + dir) * 512 + ch];
            u16* dst = Gt + (size_t)row * 2048 + which * 512 + ch;
            dst[0] = f2bf(sigmoidf_(v0 + bias)); dst[2048] = f2bf(sigmoidf_(v1 + bias));
            dst[4096] = f2bf(sigmoidf_(v2 + bias)); dst[6144] = f2bf(sigmoidf_(v3 + bias));
          });
        }
      }
    }
    GSYNC();
    DBG_AT(4, dbg_xor(p, qb, 768, 768, kn, 512, 512, Gt, 2048, 2048, vml, 1024, 1024));
  if (PHASE_MASK & 16)
    {
      const int r = tid_l() & 31;
      const int NITEMS = 384 + 1024 + 256 + 256;
      for (;;) {
        if (tid == 0) s_item = atomicAdd(&ctr[l * 64], 1);
        __syncthreads();
        const int it = s_item;
        __syncthreads();
        if (it >= NITEMS) break;
        if (it < 384) {
          scan_sum_item(p, l, it);
        } else if (it < 1408) {
          const int idx = it - 384, qt = idx & 127, kvh = (idx >> 7) & 1, b = idx >> 8;
          const int q0 = qt * 32, hq = kvh * 4 + wave;
          const int rowq = NCTX + b * 4096 + q0 + r;
          const float sc = 0.125f * LOG2E;
          const float sk = p.in[16][l * 8 + hq] * LOG2E;
          AttnState<4> st;
          attn_init<4>(st, P + (size_t)rowq * PP + C_QA + hq * 64, 1, sk);
          {
            const int kbeg = q0 - 128 < 0 ? 0 : q0 - 128, kend = q0 + 160 > 4096 ? 4096 : q0 + 160;
            gqa_staged<true>(st, P + (size_t)(NCTX + b * 4096) * PP + C_KA + kvh * 64, PP,
                             vgl + (size_t)(b * 2 + kvh) * 64 * 4608, 4608, kbeg, (kend - kbeg) >> 5,
                             ck + (size_t)(b * 4 + l) * 512 * 128 + kvh * 64, 128,
                             (const u16*)(ws + WS_VCT) + (size_t)((b * 4 + l) * 2 + kvh) * 64 * 512, 512, 16, sc, q0 + r, smem);
          }
          attn_finish<4>(st, 1, sk, (u16*)(ws + WS_YA) + (size_t)rowq * 512 + hq * 64);
        } else if (it < 1664) {
          const int idx = it - 1408, qblk = idx & 1, hh = (idx >> 1) & 7, b = idx >> 4;
          const int q0 = qblk * 128 + wave * 32;
          const int rowq = b * 256 + q0 + r;
          const float sc = 0.10206207261596577f * LOG2E;
          AttnState<6> st;
          attn_init<6>(st, qb + (size_t)rowq * 768 + hh * 96, 0, 0.f);
          attn_seg<6, false>(st, kn + (size_t)(b * 256) * 512 + hh * 64, 512, P + (size_t)(b * 256) * PP + C_KR, PP,
                             vmc + (size_t)(b * 8 + hh) * 64 * 256, 256, 0, 256, sc, 0);
          attn_finish<6>(st, 0, 0.f, (u16*)(ws + WS_YB) + (size_t)rowq * 512 + hh * 64);
        } else {
          const int idx = it - 1664, qt = idx & 7, kvh = (idx >> 3) & 1, b = idx >> 4;
          const int q0 = qt * 32, hq = kvh * 4 + wave;
          const int rowq = b * 256 + q0 + r;
          const float sc = 0.125f * LOG2E;
          const float sk = p.in[16][l * 8 + hq] * LOG2E;
          AttnState<4> st;
          attn_init<4>(st, P + (size_t)rowq * PP + C_QA + hq * 64, 1, sk);
          gqa_staged<false>(st, P + (size_t)(b * 256) * PP + C_KA + kvh * 64, PP, vgc + (size_t)(b * 2 + kvh) * 64 * 256, 256, 0, 8,
                            nullptr, 0, nullptr, 0, 0, sc, 0, smem);
          attn_finish<4>(st, 1, sk, (u16*)(ws + WS_YA) + (size_t)rowq * 512 + hq * 64);
        }
      }
    }
    GSYNC();
  if (PHASE_MASK & 16)
    {
      const int r = tid_l() & 31;
      const int NITEMS = 384 + 1024;
      bool scans_left = true;
      int steal = 0;
      const int xcc = (int)(xb.x & 7u);
      for (;;) {
        if (tid == 0) {
          int v = -1;
          while (v < 0 && steal < 8) {
            const int q = (xcc + steal) & 7;
            const int j = atomicAdd(&ctr[l * 64 + 40 + q], 1);
            if (j < 128) v = 384 + q * 128 + j; else ++steal;
          }
          if (v < 0 && scans_left) { v = atomicAdd(&ctr[l * 64 + 32], 1); if (v >= 384) { v = -1; scans_left = false; } }
          s_item = v < 0 ? (1 << 30) : v;
        }
        __syncthreads();
        const int it = s_item;
        __syncthreads();
        if (it >= NITEMS) break;
        if (it < 384) {
          scan_apply_item(p, l, it);
        } else {
          const int idx = it - 384, qblk = idx & 31, hh = (idx >> 5) & 7, b = idx >> 8;
          const int q0 = qblk * 128 + wave * 32;
          const int rowq = NCTX + b * 4096 + q0 + r;
          const float sc = 0.10206207261596577f * LOG2E;
          for (int rep = 0; rep < REP_MLA; ++rep) {
          AttnState<6> st;
          attn_init<6>(st, qb + (size_t)rowq * 768 + hh * 96, 0, 0.f);
          mla_latent_item(st, kn + (size_t)(NCTX + b * 4096) * 512 + hh * 64, P + (size_t)(NCTX + b * 4096) * PP + C_KR,
                          kn + (size_t)(T + b * 512) * 512 + hh * 64, ckr + (size_t)(b * 4 + l) * 512 * 32,
                          vml + (size_t)(b * 8 + hh) * 64 * 4608, sc, smem);
          attn_finish<6>(st, 0, 0.f, (u16*)(ws + WS_YB) + (size_t)rowq * 512 + hh * 64);
          }
        }
      }
    }
    GSYNC();
    DBG_AT(5, dbg_xor(p, (const u16*)(ws + WS_YC), 512, 512));
  if (PHASE_MASK & 32)
    {
      u16* Mb = (u16*)(ws + WS_M);
      for (int t = blockIdx.x; t < 160 * 8; t += NB) {
        const int mt = (t & 7) + 8 * (t >> 6), nt = (t >> 3) & 7, m0 = mt * 128, n0 = nt * 128;
        unsigned mpk[2][2][8];
#pragma unroll
        for (int i = 0; i < 2; ++i)
#pragma unroll
          for (int j = 0; j < 2; ++j)
#pragma unroll
            for (int e = 0; e < 8; ++e) mpk[i][j][e] = 0u;
#pragma unroll 1
        for (int n = 0; n < 3; ++n) {
          f32x16 acc[2][2];
          zero_acc<2>(acc);
          gemm_mainloop<2>(Hb + (size_t)m0 * 1024, 1024, wt + WT_IN + (size_t)(C_GL + n * 1024 + n0) * 1024, 1024, 128, 1024, smem, acc);
          gemm_epilogue<2>(acc, [&](int rr, int cc, float v0, float v1, float v2, float v3) {
            u16* dst = Mb + (size_t)(m0 + rr) * 1024 + n0 + cc;
            dst[0] = f2bf(sigmoidf_(v0)); dst[1024] = f2bf(sigmoidf_(v1)); dst[2048] = f2bf(sigmoidf_(v2)); dst[3072] = f2bf(sigmoidf_(v3));
          });
          zero_acc<2>(acc);
          const u16* Y = (const u16*)(ws + WS_YA) + (size_t)n * T * 512;
          gemm_mainloop<2>(Y + (size_t)m0 * 512, 512, wt + WT_BR + (size_t)(n * 1024 + n0) * 512, 512, 128, 512, smem, acc);
          {
            const int tid3 = tid_l(), lane3 = tid3 & 63, wave3 = tid3 >> 6, r3 = lane3 & 31, h3 = lane3 >> 5;
            const int wm3 = wave3 >> 1, wn3 = wave3 & 1;
#pragma unroll
            for (int i = 0; i < 2; ++i)
#pragma unroll
              for (int j = 0; j < 2; ++j)
#pragma unroll
                for (int g = 0; g < 4; ++g) {
                  const u16* src = Mb + (size_t)(m0 + wm3 * 64 + i * 32 + 8 * g + 4 * h3) * 1024 + n0 + wn3 * 64 + j * 32 + r3;
                  const float g0 = bf2f(src[0]), g1 = bf2f(src[1024]), g2 = bf2f(src[2048]), g3 = bf2f(src[3072]);
                  mpk[i][j][2 * g] = pk2(lo_bf(mpk[i][j][2 * g]) + g0 * acc[i][j][4 * g], hi_bf(mpk[i][j][2 * g]) + g1 * acc[i][j][4 * g + 1]);
                  mpk[i][j][2 * g + 1] = pk2(lo_bf(mpk[i][j][2 * g + 1]) + g2 * acc[i][j][4 * g + 2], hi_bf(mpk[i][j][2 * g + 1]) + g3 * acc[i][j][4 * g + 3]);
                }
          }
        }
        {
          const int tid2 = tid_l(), lane2 = tid2 & 63, wave2 = tid2 >> 6, r2 = lane2 & 31, h2 = lane2 >> 5;
          const int wm2 = wave2 >> 1, wn2 = wave2 & 1;
#pragma unroll
          for (int i = 0; i < 2; ++i)
#pragma unroll
            for (int j = 0; j < 2; ++j)
#pragma unroll
              for (int g = 0; g < 4; ++g) {
                u16* dst = Mb + (size_t)(m0 + wm2 * 64 + i * 32 + 8 * g + 4 * h2) * 1024 + n0 + wn2 * 64 + j * 32 + r2;
                dst[0] = (u16)(mpk[i][j][2 * g] & 0xffffu); dst[1024] = (u16)(mpk[i][j][2 * g] >> 16);
                dst[2048] = (u16)(mpk[i][j][2 * g + 1] & 0xffffu); dst[3072] = (u16)(mpk[i][j][2 * g + 1] >> 16);
              }
        }
      }
    }
    GSYNC();
    DBG_AT(6, dbg_xor(p, (const u16*)(ws + WS_M), 1024, 1024));
  if (PHASE_MASK & 64)
    {
      const u16* Mb = (const u16*)(ws + WS_M);
      u16* Mo = (u16*)(ws + WS_MO);
      GCarry carry;
      carry.xa0 = carry.xa1 = carry.xa2 = carry.xa3 = carry.xb0 = carry.xb1 = carry.xb2 = carry.xb3 = carry.ya0 = carry.ya1 = carry.ya2 = carry.ya3 = carry.yb0 = carry.yb1 = carry.yb2 = carry.yb3 = make_uint4(0u, 0u, 0u, 0u);
      for (int rep = 0; rep < REP_GEMM; ++rep)
      for (int t = blockIdx.x; t < 160 * 8; t += NB) {
        const int mt = (t & 7) + 8 * (t >> 6), nt = (t >> 3) & 7, m0 = mt * 128, n0 = nt * 128;
        f32x16 acc[2][2];
        zero_acc<2>(acc);
        {
          const int tn_ = t + NB < 160 * 8 ? t + NB : t;
          const int mtn = (tn_ & 7) + 8 * (tn_ >> 6), ntn = (tn_ >> 3) & 7;
          gemm_stream(t == (int)blockIdx.x, carry, Mb + (size_t)m0 * 1024, 1024, wt + WT_OUT + (size_t)n0 * 1024, 1024, 128,
                      Mb + (size_t)mtn * 128 * 1024, wt + WT_OUT + (size_t)ntn * 128 * 1024, 128, 1024, smem, acc);
        }
        gemm_epilogue<2>(acc, [&](int rr, int cc, float v0, float v1, float v2, float v3) {
          u16* dst = Mo + (size_t)(m0 + rr) * 1024 + n0 + cc;
          dst[0] = f2bf(v0); dst[1024] = f2bf(v1); dst[2048] = f2bf(v2); dst[3072] = f2bf(v3);
        });
      }
    }
    GSYNC();
    DBG_AT(7, dbg_xor(p, (const u16*)(ws + WS_MO), 1024, 1024));
  if (PHASE_MASK & 128)
    phase_rows(p, l, 1);
    GSYNC();
    DBG_AT(8, dbg_xor(p, Hb, 1024, 1024));
  if (PHASE_MASK & 256)
    {
      u16* F1 = (u16*)(ws + WS_F1);
      GCarry carry;
      carry.xa0 = carry.xa1 = carry.xa2 = carry.xa3 = carry.xb0 = carry.xb1 = carry.xb2 = carry.xb3 = carry.ya0 = carry.ya1 = carry.ya2 = carry.ya3 = carry.yb0 = carry.yb1 = carry.yb2 = carry.yb3 = make_uint4(0u, 0u, 0u, 0u);
      for (int rep = 0; rep < REP_GEMM; ++rep)
      for (int t = blockIdx.x; t < 160 * 32; t += NB) {
        const int mt = (t & 7) + 8 * (t >> 8), nt = (t >> 3) & 31, m0 = mt * 128, n0 = nt * 128;
        f32x16 acc[2][2];
        zero_acc<2>(acc);
        {
          const int tn_ = t + NB < 160 * 32 ? t + NB : t;
          const int mtn = (tn_ & 7) + 8 * (tn_ >> 8), ntn = (tn_ >> 3) & 31;
          gemm_stream(t == (int)blockIdx.x, carry, Hb + (size_t)m0 * 1024, 1024, wt + WT_FF1 + (size_t)n0 * 1024, 1024, 128,
                      Hb + (size_t)mtn * 128 * 1024, wt + WT_FF1 + (size_t)ntn * 128 * 1024, 128, 1024, smem, acc);
        }
        gemm_epilogue<2>(acc, [&](int rr, int cc, float v0, float v1, float v2, float v3) {
          u16* dst = F1 + (size_t)(m0 + rr) * 4096 + n0 + cc;
          v0 = fmaxf(v0, 0.f); v1 = fmaxf(v1, 0.f); v2 = fmaxf(v2, 0.f); v3 = fmaxf(v3, 0.f);
          dst[0] = f2bf(v0 * v0); dst[4096] = f2bf(v1 * v1); dst[8192] = f2bf(v2 * v2); dst[12288] = f2bf(v3 * v3);
        });
      }
    }
    GSYNC();
    DBG_AT(9, dbg_xor(p, (const u16*)(ws + WS_F1), 4096, 4096));
  if (PHASE_MASK & 512)
    {
      const u16* F1 = (const u16*)(ws + WS_F1);
      u16* F2 = (u16*)(ws + WS_M);
      GCarry carry;
      carry.xa0 = carry.xa1 = carry.xa2 = carry.xa3 = carry.xb0 = carry.xb1 = carry.xb2 = carry.xb3 = carry.ya0 = carry.ya1 = carry.ya2 = carry.ya3 = carry.yb0 = carry.yb1 = carry.yb2 = carry.yb3 = make_uint4(0u, 0u, 0u, 0u);
      for (int rep = 0; rep < REP_GEMM; ++rep)
      for (int t = blockIdx.x; t < 160 * 8; t += NB) {
        const int mt = (t & 7) + 8 * (t >> 6), nt = (t >> 3) & 7, m0 = mt * 128, n0 = nt * 128;
        f32x16 acc[2][2];
        zero_acc<2>(acc);
        {
          const int tn_ = t + NB < 160 * 8 ? t + NB : t;
          const int mtn = (tn_ & 7) + 8 * (tn_ >> 6), ntn = (tn_ >> 3) & 7;
          gemm_stream(t == (int)blockIdx.x, carry, F1 + (size_t)m0 * 4096, 4096, wt + WT_FF2 + (size_t)n0 * 4096, 4096, 128,
                      F1 + (size_t)mtn * 128 * 4096, wt + WT_FF2 + (size_t)ntn * 128 * 4096, 128, 4096, smem, acc);
        }
        gemm_epilogue<2>(acc, [&](int rr, int cc, float v0, float v1, float v2, float v3) {
          u16* dst = F2 + (size_t)(m0 + rr) * 1024 + n0 + cc;
          dst[0] = f2bf(v0); dst[1024] = f2bf(v1); dst[2048] = f2bf(v2); dst[3072] = f2bf(v3);
        });
      }
    }
    GSYNC();
    DBG_AT(10, dbg_xor(p, (const u16*)(ws + WS_M), 1024, 1024));
  if (PHASE_MASK & 1024)
    phase_rows(p, l, 2);
    if (l + 1 < DEPTH) {
      transpose_layer(p, l + 1, (float*)smem);
      GSYNC();
    }
  }
}

extern "C" void kernel_launch(void* const* d_in, const int* in_sizes, int n_in, void* d_out, int out_size, void* d_ws,
                              size_t ws_size, hipStream_t stream) {
  if (ws_size < WS_END || n_in < 33) {
    fprintf(stderr, "workspace too small: %zu < %zu\n", ws_size, (size_t)WS_END);
    return;
  }
  static int grid_blocks = 0;
  if (!grid_blocks) {
    int dev = 0, cus = 0, per_cu = 0;
    hipGetDevice(&dev);
    hipDeviceGetAttribute(&cus, hipDeviceAttributeMultiprocessorCount, dev);
    hipOccupancyMaxActiveBlocksPerMultiprocessor(&per_cu, fwd_megakernel, 256, 0);
    if (per_cu > 2) per_cu = 2;
    if (per_cu < 1) per_cu = 1;
    grid_blocks = cus * per_cu;
  }
  Params p{};
  for (int i = 0; i < 33; ++i) p.in[i] = (const float*)d_in[i];
  p.out = (float*)d_out;
  p.ws = (char*)d_ws;
  hipMemsetAsync(d_ws, 0, WS_ZERO_BYTES, stream);
  void* args[] = {&p};
  hipError_t e = hipLaunchCooperativeKernel((void*)fwd_megakernel, dim3(grid_blocks), dim3(256), args, 0, stream);
  if (e != hipSuccess) fprintf(stderr, "cooperative launch failed: %s (grid %d)\n", hipGetErrorString(e), grid_blocks);
}
```

```cpp
#include <hip/hip_runtime.h>
#include <hip/hip_cooperative_groups.h>
#include <stdint.h>
#include <stdio.h>
namespace cg = cooperative_groups;

#define DI __device__ __forceinline__
#define GSYNC() xcd_barrier(xb)
#define DBG_SKIP_FF2 0
#define DBG_NOROPE 0
#ifndef REP_GEMM
#define REP_GEMM 1
#endif
#ifndef REP_MLA
#define REP_MLA 1
#endif
#ifndef REP_SCAN
#define REP_SCAN 1
#endif
#ifndef PHASE_MASK
#define PHASE_MASK 0xFFFF
#endif
typedef unsigned short u16;
typedef __attribute__((ext_vector_type(8))) short bf16x8;
typedef __attribute__((ext_vector_type(16))) float f32x16;
typedef __attribute__((ext_vector_type(2))) float f32x2;
typedef __attribute__((ext_vector_type(2))) __bf16 bf2_t;

constexpr int DM = 1024, T = 20480, TC = 22528, NCTX = 4096, DEPTH = 4;
constexpr int PW = 2464;
constexpr int PP = 2496;
constexpr int C_QA = 0, C_KA = 512, C_VA = 640, C_CQ = 768, C_CKV = 1152, C_KR = 1408, C_XC = 1440, C_GC = 1952, C_GL = 2464;
constexpr int INC = 5536;
constexpr float EPS = 1e-6f;
constexpr float LOG2E = 1.4426950408889634f;

constexpr size_t O_Y = 0, O_K = 20971520, O_V = 23068672, O_CKV = 25165824, O_KR = 29360128, O_ST = 29884416;

constexpr size_t al256(size_t x) { return (x + 255) & ~(size_t)255; }
constexpr size_t WS_BAR = 0;
constexpr size_t WS_CTR = 16384;
constexpr size_t WS_MOD = 65536;
constexpr size_t WS_ZERO_BYTES = 65536;
constexpr size_t WS_MOD_END = WS_MOD + (size_t)4 * 5 * 6144 * 4;
constexpr size_t WS_TAB16 = al256(WS_MOD_END);
constexpr size_t WS_TAB8 = WS_TAB16 + 64 * 16 * 8;
constexpr size_t WS_CK = al256(WS_TAB8 + 64 * 8 * 8);
constexpr size_t WS_CKR = WS_CK + (size_t)16 * 512 * 128 * 2;
constexpr size_t WS_VCT = WS_CKR + (size_t)16 * 512 * 32 * 2;
constexpr size_t WS_WT = al256(WS_VCT + (size_t)16 * 2 * 64 * 512 * 2);
constexpr size_t WT_IN = 0;
constexpr size_t WT_QUP = WT_IN + (size_t)5536 * 1024;
constexpr size_t WT_KV = WT_QUP + (size_t)768 * 384;
constexpr size_t WT_G = WT_KV + (size_t)1024 * 256;
constexpr size_t WT_BR = WT_G + (size_t)8 * 256 * 64;
constexpr size_t WT_OUT = WT_BR + (size_t)3 * 1024 * 512;
constexpr size_t WT_FF1 = WT_OUT + (size_t)1024 * 1024;
constexpr size_t WT_FF2 = WT_FF1 + (size_t)4096 * 1024;
constexpr size_t WT_ELEMS = WT_FF2 + (size_t)1024 * 4096;
constexpr size_t WS_H = al256(WS_WT + WT_ELEMS * 2);
constexpr size_t WS_P = al256(WS_H + (size_t)T * 1024 * 2);
constexpr size_t WS_G = WS_P + (size_t)T * PP * 2;
constexpr size_t WS_CKVN = al256(WS_G + (size_t)T * 2048 * 2);
constexpr size_t WS_XCV = WS_CKVN + (size_t)TC * 256 * 2;
constexpr size_t WS_QB = al256(WS_XCV + (size_t)T * 512 * 2);
constexpr size_t WS_KN = WS_QB + (size_t)T * 768 * 2;
constexpr size_t WS_VML = al256(WS_KN + (size_t)TC * 512 * 2);
constexpr size_t WS_VMC = WS_VML + (size_t)4 * 8 * 64 * 4608 * 2;
constexpr size_t WS_VGL = WS_VMC + (size_t)16 * 8 * 64 * 256 * 2;
constexpr size_t WS_VGC = WS_VGL + (size_t)4 * 2 * 64 * 4608 * 2;
constexpr size_t WS_YA = al256(WS_VGC + (size_t)16 * 2 * 64 * 256 * 2);
constexpr size_t WS_YB = WS_YA + (size_t)T * 512 * 2;
constexpr size_t WS_YC = WS_YB + (size_t)T * 512 * 2;
constexpr size_t WS_SUM = al256(WS_YC + (size_t)T * 512 * 2);
constexpr size_t WS_END = WS_SUM + (size_t)20 * 8 * 32 * 256 * 4;
constexpr size_t WS_F1 = WS_P;
constexpr size_t WS_MO = WS_G;
constexpr size_t WS_M = WS_QB;

struct Params {
  const float* in[33];
  float* out;
  char* ws;
};

DI int tid_l() { int t = threadIdx.x; asm volatile("" : "+v"(t)); return t; }
DI float bf2f(u16 v) { return __uint_as_float(((unsigned)v) << 16); }
DI unsigned pk2(float a, float b) {
  f32x2 v = {a, b};
  bf2_t r = __builtin_convertvector(v, bf2_t);
  return __builtin_bit_cast(unsigned, r);
}
DI u16 f2bf(float a) { return (u16)(pk2(a, 0.f) & 0xffffu); }
DI float lo_bf(unsigned u) { return __uint_as_float(u << 16); }
DI float hi_bf(unsigned u) { return __uint_as_float(u & 0xffff0000u); }
DI float wsum(float v) {
#pragma unroll
  for (int o = 32; o > 0; o >>= 1) v += __shfl_xor(v, o, 64);
  return v;
}
DI float sigmoidf_(float x) { return 1.f / (1.f + __expf(-x)); }
DI int grp_of(int r) { return r < NCTX ? 0 : 1 + ((r - NCTX) >> 12); }
DI const float* xin_row(const Params& p, int r) {
  return r < NCTX ? p.in[0] + (size_t)r * DM : p.in[1] + (size_t)(r - NCTX) * DM;
}
#define MFMA32(a, b, c) __builtin_amdgcn_mfma_f32_32x32x16_bf16((a), (b), (c), 0, 0, 0)

constexpr int LROW = 72;
constexpr int SMEM_BYTES = 4 * 128 * LROW * 2;

template <int TN>
struct GStage {
  uint4 a[4];
  uint4 b[2 * TN];
};
template <int TN>
DI void g_load(GStage<TN>& st, const u16* pa, int lda, const u16* const (&pb)[2 * TN], int k0) {
#pragma unroll
  for (int i = 0; i < 4; ++i) st.a[i] = *(const uint4*)(pa + (size_t)(32 * i) * lda + k0);
#pragma unroll
  for (int i = 0; i < 2 * TN; ++i) st.b[i] = *(const uint4*)(pb[i] + k0);
}
template <int TN>
DI void g_store(const GStage<TN>& st, u16* sA, u16* sB, int buf, int lrow, int lch) {
#pragma unroll
  for (int i = 0; i < 4; ++i) *(uint4*)(sA + (buf * 128 + lrow + 32 * i) * LROW + lch * 8) = st.a[i];
#pragma unroll
  for (int i = 0; i < 2 * TN; ++i) *(uint4*)(sB + (buf * 128 + lrow + 32 * i) * LROW + lch * 8) = st.b[i];
}
template <int TN>
DI void g_mma(const u16* sA, const u16* sB, int buf, int wm, int wn, int r, int h, f32x16 (&acc)[2][TN]) {
  const u16* cA = sA + (buf * 128 + wm * 64 + r) * LROW + h * 8;
  const u16* cB = sB + (buf * 128 + wn * 32 * TN + r) * LROW + h * 8;
#pragma unroll
  for (int ks = 0; ks < 4; ++ks) {
    bf16x8 a_[2], b_[TN];
#pragma unroll
    for (int i = 0; i < 2; ++i) a_[i] = *(const bf16x8*)(cA + i * 32 * LROW + ks * 16);
#pragma unroll
    for (int j = 0; j < TN; ++j) b_[j] = *(const bf16x8*)(cB + j * 32 * LROW + ks * 16);
#pragma unroll
    for (int i = 0; i < 2; ++i)
#pragma unroll
      for (int j = 0; j < TN; ++j) acc[i][j] = MFMA32(a_[i], b_[j], acc[i][j]);
  }
}

template <int TN>
DI void gemm_mainloop(const u16* __restrict__ A, int lda, const u16* __restrict__ B, int ldb, int nvalid, int K,
                      u16* smem, f32x16 (&acc)[2][TN]) {
  static_assert(TN == 2, "only the 128x128 tile is used");
  const int tid = tid_l(), lane = tid & 63, wave = tid >> 6;
  const int r = lane & 31, h = lane >> 5;
  const int wm = wave >> 1, wn = wave & 1;
  u16* sA = smem;
  u16* sB = smem + 2 * 128 * LROW;
  const int lrow = tid >> 3, lch = tid & 7;
  const u16* pa = A + (size_t)lrow * lda + lch * 8;
  (void)nvalid;
  const u16* pb = B + (size_t)lrow * ldb + lch * 8;
  const int nk = K >> 6, kmax = K - 64;
  u16* wA = sA + lrow * LROW + lch * 8;
  u16* wB = sB + lrow * LROW + lch * 8;
  uint4 xa0, xa1, xa2, xa3, xb0, xb1, xb2, xb3, ya0, ya1, ya2, ya3, yb0, yb1, yb2, yb3;
  {
    const uint4 t0 = *(const uint4*)(pa), t1 = *(const uint4*)(pa + (size_t)32 * lda), t2 = *(const uint4*)(pa + (size_t)64 * lda),
                t3 = *(const uint4*)(pa + (size_t)96 * lda);
    const uint4 u0 = *(const uint4*)(pb), u1 = *(const uint4*)(pb + (size_t)32 * ldb), u2 = *(const uint4*)(pb + (size_t)64 * ldb), u3 = *(const uint4*)(pb + (size_t)96 * ldb);
    *(uint4*)(wA) = t0; *(uint4*)(wA + 32 * LROW) = t1; *(uint4*)(wA + 64 * LROW) = t2; *(uint4*)(wA + 96 * LROW) = t3;
    *(uint4*)(wB) = u0; *(uint4*)(wB + 32 * LROW) = u1; *(uint4*)(wB + 64 * LROW) = u2; *(uint4*)(wB + 96 * LROW) = u3;
  }
  {
    const int k1 = 64 < kmax ? 64 : kmax, k2 = 128 < kmax ? 128 : kmax;
    xa0 = *(const uint4*)(pa + k1); xa1 = *(const uint4*)(pa + (size_t)32 * lda + k1);
    xa2 = *(const uint4*)(pa + (size_t)64 * lda + k1); xa3 = *(const uint4*)(pa + (size_t)96 * lda + k1);
    xb0 = *(const uint4*)(pb + k1); xb1 = *(const uint4*)(pb + (size_t)32 * ldb + k1); xb2 = *(const uint4*)(pb + (size_t)64 * ldb + k1); xb3 = *(const uint4*)(pb + (size_t)96 * ldb + k1);
    ya0 = *(const uint4*)(pa + k2); ya1 = *(const uint4*)(pa + (size_t)32 * lda + k2);
    ya2 = *(const uint4*)(pa + (size_t)64 * lda + k2); ya3 = *(const uint4*)(pa + (size_t)96 * lda + k2);
    yb0 = *(const uint4*)(pb + k2); yb1 = *(const uint4*)(pb + (size_t)32 * ldb + k2); yb2 = *(const uint4*)(pb + (size_t)64 * ldb + k2); yb3 = *(const uint4*)(pb + (size_t)96 * ldb + k2);
  }
  __syncthreads();
#define SUBSTEPM(S, Q, BUF, OK)                                                                               \
  {                                                                                                           \
    const u16* cA_ = sA + ((BUF) * 128 + wm * 64 + r) * LROW + h * 8 + (Q) * 16;                              \
    const u16* cB_ = sB + ((BUF) * 128 + wn * 64 + r) * LROW + h * 8 + (Q) * 16;                              \
    const bf16x8 fa0 = *(const bf16x8*)(cA_), fa1 = *(const bf16x8*)(cA_ + 32 * LROW);                        \
    const bf16x8 fb0 = *(const bf16x8*)(cB_), fb1 = *(const bf16x8*)(cB_ + 32 * LROW);                        \
    acc[0][0] = MFMA32(fa0, fb0, acc[0][0]);                                                                  \
    acc[0][1] = MFMA32(fa0, fb1, acc[0][1]);                                                                  \
    acc[1][0] = MFMA32(fa1, fb0, acc[1][0]);                                                                  \
    acc[1][1] = MFMA32(fa1, fb1, acc[1][1]);                                                                  \
    *(uint4*)(wA + (((BUF) ^ 1) * 128 + 32 * (Q)) * LROW) = S##a##Q;                                          \
    *(uint4*)(wB + (((BUF) ^ 1) * 128 + 32 * (Q)) * LROW) = S##b##Q;                                          \
    S##a##Q = *(const uint4*)(pa + (size_t)(32 * (Q)) * lda + (OK));                                          \
    S##b##Q = *(const uint4*)(pb + (size_t)(32 * (Q)) * ldb + (OK));                                                                  \
  }
  for (int kt = 0; kt < nk; kt += 2) {
    {
      const int ok = ((kt + 3) << 6) < kmax ? ((kt + 3) << 6) : kmax;
      SUBSTEPM(x, 0, 0, ok) SUBSTEPM(x, 1, 0, ok) SUBSTEPM(x, 2, 0, ok) SUBSTEPM(x, 3, 0, ok)
      __syncthreads();
    }
    if (kt + 1 < nk) {
      const int ok = ((kt + 4) << 6) < kmax ? ((kt + 4) << 6) : kmax;
      SUBSTEPM(y, 0, 1, ok) SUBSTEPM(y, 1, 1, ok) SUBSTEPM(y, 2, 1, ok) SUBSTEPM(y, 3, 1, ok)
      __syncthreads();
    }
  }
#undef SUBSTEPM
}

struct GCarry {
  uint4 xa0, xa1, xa2, xa3, xb0, xb1, xb2, xb3, ya0, ya1, ya2, ya3, yb0, yb1, yb2, yb3;
};
DI void gemm_stream(bool first, GCarry& c, const u16* __restrict__ A, int lda, const u16* __restrict__ B, int ldb, int  ,
                    const u16* __restrict__ An, const u16* __restrict__ Bn, int  , int K, u16* smem,
                    f32x16 (&acc)[2][2]) {
  const int tid = tid_l(), lane = tid & 63, wave = tid >> 6;
  const int r = lane & 31, h = lane >> 5;
  const int wm = wave >> 1, wn = wave & 1;
  u16* sA = smem;
  u16* sB = smem + 2 * 128 * LROW;
  const int lrow = tid >> 3, lch = tid & 7;
  const u16* pa = A + (size_t)lrow * lda + lch * 8;
  const u16* pb = B + (size_t)lrow * ldb + lch * 8;
  const long dA = An - A, dB = Bn - B;
  const int nk = K >> 6;
  uint4 xa0 = c.xa0, xa1 = c.xa1, xa2 = c.xa2, xa3 = c.xa3, xb0 = c.xb0, xb1 = c.xb1, xb2 = c.xb2, xb3 = c.xb3;
  uint4 ya0 = c.ya0, ya1 = c.ya1, ya2 = c.ya2, ya3 = c.ya3, yb0 = c.yb0, yb1 = c.yb1, yb2 = c.yb2, yb3 = c.yb3;
  u16* wA = sA + lrow * LROW + lch * 8;
  u16* wB = sB + lrow * LROW + lch * 8;
  if (first) {
    {
      const uint4 t0 = *(const uint4*)(pa), t1 = *(const uint4*)(pa + (size_t)32 * lda), t2 = *(const uint4*)(pa + (size_t)64 * lda),
                  t3 = *(const uint4*)(pa + (size_t)96 * lda);
      const uint4 u0 = *(const uint4*)(pb), u1 = *(const uint4*)(pb + (size_t)32 * ldb), u2 = *(const uint4*)(pb + (size_t)64 * ldb),
                  u3 = *(const uint4*)(pb + (size_t)96 * ldb);
      *(uint4*)(wA) = t0; *(uint4*)(wA + 32 * LROW) = t1; *(uint4*)(wA + 64 * LROW) = t2; *(uint4*)(wA + 96 * LROW) = t3;
      *(uint4*)(wB) = u0; *(uint4*)(wB + 32 * LROW) = u1; *(uint4*)(wB + 64 * LROW) = u2; *(uint4*)(wB + 96 * LROW) = u3;
    }
    xa0 = *(const uint4*)(pa + 64); xa1 = *(const uint4*)(pa + (size_t)32 * lda + 64);
    xa2 = *(const uint4*)(pa + (size_t)64 * lda + 64); xa3 = *(const uint4*)(pa + (size_t)96 * lda + 64);
    xb0 = *(const uint4*)(pb + 64); xb1 = *(const uint4*)(pb + (size_t)32 * ldb + 64);
    xb2 = *(const uint4*)(pb + (size_t)64 * ldb + 64); xb3 = *(const uint4*)(pb + (size_t)96 * ldb + 64);
    ya0 = *(const uint4*)(pa + 128); ya1 = *(const uint4*)(pa + (size_t)32 * lda + 128);
    ya2 = *(const uint4*)(pa + (size_t)64 * lda + 128); ya3 = *(const uint4*)(pa + (size_t)96 * lda + 128);
    yb0 = *(const uint4*)(pb + 128); yb1 = *(const uint4*)(pb + (size_t)32 * ldb + 128);
    yb2 = *(const uint4*)(pb + (size_t)64 * ldb + 128); yb3 = *(const uint4*)(pb + (size_t)96 * ldb + 128);
    __syncthreads();
  }
#define SUBSTEP(S, Q, BUF, OA, OB)                                                                            \
  {                                                                                                           \
    const u16* cA_ = sA + ((BUF) * 128 + wm * 64 + r) * LROW + h * 8 + (Q) * 16;                              \
    const u16* cB_ = sB + ((BUF) * 128 + wn * 64 + r) * LROW + h * 8 + (Q) * 16;                              \
    const bf16x8 fa0 = *(const bf16x8*)(cA_), fa1 = *(const bf16x8*)(cA_ + 32 * LROW);                        \
    const bf16x8 fb0 = *(const bf16x8*)(cB_), fb1 = *(const bf16x8*)(cB_ + 32 * LROW);                        \
    acc[0][0] = MFMA32(fa0, fb0, acc[0][0]);                                                                  \
    acc[0][1] = MFMA32(fa0, fb1, acc[0][1]);                                                                  \
    acc[1][0] = MFMA32(fa1, fb0, acc[1][0]);                                                                  \
    acc[1][1] = MFMA32(fa1, fb1, acc[1][1]);                                                                  \
    *(uint4*)(wA + (((BUF) ^ 1) * 128 + 32 * (Q)) * LROW) = S##a##Q;                                          \
    *(uint4*)(wB + (((BUF) ^ 1) * 128 + 32 * (Q)) * LROW) = S##b##Q;                                          \
    S##a##Q = *(const uint4*)(pa + (size_t)(32 * (Q)) * lda + (OA));                                          \
    S##b##Q = *(const uint4*)(pb + (size_t)(32 * (Q)) * ldb + (OB));                                          \
  }
  for (int kt = 0; kt < nk; kt += 2) {
    {
      const int j = kt + 3;
      const long oA = j < nk ? (long)j * 64 : dA + (long)(j - nk) * 64, oB = j < nk ? (long)j * 64 : dB + (long)(j - nk) * 64;
      SUBSTEP(x, 0, 0, oA, oB) SUBSTEP(x, 1, 0, oA, oB) SUBSTEP(x, 2, 0, oA, oB) SUBSTEP(x, 3, 0, oA, oB)
      __syncthreads();
    }
    {
      const int j = kt + 4;
      const long oA = j < nk ? (long)j * 64 : dA + (long)(j - nk) * 64, oB = j < nk ? (long)j * 64 : dB + (long)(j - nk) * 64;
      SUBSTEP(y, 0, 1, oA, oB) SUBSTEP(y, 1, 1, oA, oB) SUBSTEP(y, 2, 1, oA, oB) SUBSTEP(y, 3, 1, oA, oB)
      __syncthreads();
    }
  }
#undef SUBSTEP
  c.xa0 = xa0; c.xa1 = xa1; c.xa2 = xa2; c.xa3 = xa3; c.xb0 = xb0; c.xb1 = xb1; c.xb2 = xb2; c.xb3 = xb3;
  c.ya0 = ya0; c.ya1 = ya1; c.ya2 = ya2; c.ya3 = ya3; c.yb0 = yb0; c.yb1 = yb1; c.yb2 = yb2; c.yb3 = yb3;
}

template <int TN>
DI void zero_acc(f32x16 (&acc)[2][TN]) {
#pragma unroll
  for (int i = 0; i < 2; ++i)
#pragma unroll
    for (int j = 0; j < TN; ++j)
#pragma unroll
      for (int e = 0; e < 16; ++e) acc[i][j][e] = 0.f;
}

template <int TN, class Epi>
DI void gemm_epilogue(f32x16 (&acc)[2][TN], Epi epi) {
  const int tid = tid_l(), lane = tid & 63, wave = tid >> 6;
  const int r = lane & 31, h = lane >> 5;
  const int wm = wave >> 1, wn = wave & 1;
#pragma unroll
  for (int i = 0; i < 2; ++i)
#pragma unroll
    for (int j = 0; j < TN; ++j)
#pragma unroll
      for (int g = 0; g < 4; ++g)
        epi(wm * 64 + i * 32 + 8 * g + 4 * h, wn * 32 * TN + j * 32 + r, acc[i][j][4 * g], acc[i][j][4 * g + 1],
            acc[i][j][4 * g + 2], acc[i][j][4 * g + 3]);
}

DI void transpose_tile(const float* __restrict__ src, int ldn, u16* __restrict__ dst, int ldk, int tk, int tn, float* sT) {
  const int tid = tid_l();
  {
    const int kk = tid >> 3, n4 = (tid & 7) * 4;
#pragma unroll
    for (int ps = 0; ps < 2; ++ps) {
      typedef __attribute__((ext_vector_type(4))) float f32x4_t;
      const f32x4_t v = __builtin_nontemporal_load((const f32x4_t*)(src + (size_t)(tk * 64 + kk + 32 * ps) * ldn + tn * 32 + n4));
      sT[(n4 + 0) * 65 + kk + 32 * ps] = v.x;
      sT[(n4 + 1) * 65 + kk + 32 * ps] = v.y;
      sT[(n4 + 2) * 65 + kk + 32 * ps] = v.z;
      sT[(n4 + 3) * 65 + kk + 32 * ps] = v.w;
    }
  }
  __syncthreads();
  {
    const int n = tid >> 3, k8 = (tid & 7) * 8;
    const float* s = sT + n * 65 + k8;
    uint4 o;
    o.x = pk2(s[0], s[1]);
    o.y = pk2(s[2], s[3]);
    o.z = pk2(s[4], s[5]);
    o.w = pk2(s[6], s[7]);
    *(uint4*)(dst + (size_t)(tn * 32 + n) * ldk + tk * 64 + k8) = o;
  }
  __syncthreads();
}

DI void transpose_job(const float* src, int ldn, u16* dst, int ldk, int K, int N, float* sT, int rot) {
  const int ntk = K >> 6, nt = ntk * (N >> 5);
  int start = (int)blockIdx.x - rot;
  if (start < 0) start += gridDim.x;
  for (int t = start; t < nt; t += gridDim.x) transpose_tile(src, ldn, dst, ldk, t % ntk, t / ntk, sT);
}

DI void transpose_layer(const Params& p, int l, float* sT) {
  u16* wt = (u16*)(p.ws + WS_WT);
  const int G = gridDim.x;
  int rot = 0;
  transpose_job(p.in[15] + (size_t)l * 1024 * INC, INC, wt + WT_IN, 1024, 1024, INC, sT, rot);
  rot = (rot + 16 * 173) % G;
  transpose_job(p.in[18] + (size_t)l * 384 * 768, 768, wt + WT_QUP, 384, 384, 768, sT, rot);
  rot = (rot + 6 * 24) % G;
  transpose_job(p.in[20] + (size_t)l * 256 * 512, 512, wt + WT_KV, 256, 256, 512, sT, rot);
  rot = (rot + 4 * 16) % G;
  transpose_job(p.in[21] + (size_t)l * 256 * 512, 512, wt + WT_KV + (size_t)512 * 256, 256, 256, 512, sT, rot);
  rot = (rot + 4 * 16) % G;
  {
    int start = (int)blockIdx.x - rot;
    if (start < 0) start += G;
    for (int t = start; t < 64; t += G) {
      const int job = t >> 1, tn = t & 1;
      const int n = job & 7, which = (job >> 3) & 1, dir = job >> 4;
      const float* src = (which ? p.in[27] : p.in[25]) + (size_t)(((l * 2 + dir) * 8 + n)) * 4096;
      transpose_tile(src, 64, wt + WT_G + (size_t)(n * 256 + (dir * 2 + which) * 64) * 64, 64, 0, tn, sT);
    }
    rot = (rot + 64) % G;
  }
  for (int n = 0; n < 3; ++n) {
    transpose_job(p.in[29] + (size_t)(l * 3 + n) * 512 * 1024, 1024, wt + WT_BR + (size_t)n * 1024 * 512, 512, 512, 1024, sT, rot);
    rot = (rot + 8 * 32) % G;
  }
  transpose_job(p.in[30] + (size_t)l * 1024 * 1024, 1024, wt + WT_OUT, 1024, 1024, 1024, sT, rot);
  rot = (rot + 16 * 32) % G;
  if (l == 0 || !DBG_SKIP_FF2) transpose_job(p.in[31] + (size_t)l * 1024 * 4096, 4096, wt + WT_FF1, 1024, 1024, 4096, sT, rot);
  rot = (rot + 16 * 128) % G;
  if (l == 0 || !DBG_SKIP_FF2) transpose_job(p.in[32] + (size_t)l * 4096 * 1024, 1024, wt + WT_FF2, 4096, 4096, 1024, sT, rot);
}

DI void row_resnorm(int r, const float* xrow, const u16* f, const float* gpost, const float* gate, const float* gpre,
                    const float* sc, const float* sh, float* outx, u16* outh, int lane) {
  float x[16];
#pragma unroll
  for (int i = 0; i < 4; ++i) {
    const float4 v = *(const float4*)(xrow + (i * 64 + lane) * 4);
    x[4 * i] = v.x; x[4 * i + 1] = v.y; x[4 * i + 2] = v.z; x[4 * i + 3] = v.w;
  }
  if (f) {
    float fv[16];
    float ss = 0.f;
#pragma unroll
    for (int i = 0; i < 4; ++i) {
      const uint2 u = *(const uint2*)(f + (size_t)r * DM + (i * 64 + lane) * 4);
      fv[4 * i] = lo_bf(u.x); fv[4 * i + 1] = hi_bf(u.x); fv[4 * i + 2] = lo_bf(u.y); fv[4 * i + 3] = hi_bf(u.y);
    }
#pragma unroll
    for (int i = 0; i < 16; ++i) ss += fv[i] * fv[i];
    ss = wsum(ss);
    const float rstd = rsqrtf(ss * (1.f / DM) + EPS);
#pragma unroll
    for (int i = 0; i < 4; ++i) {
      const int idx = (i * 64 + lane) * 4;
      const float4 gp = *(const float4*)(gpost + idx);
      const float4 gt = *(const float4*)(gate + idx);
      x[4 * i] += gt.x * (fv[4 * i] * rstd * gp.x);
      x[4 * i + 1] += gt.y * (fv[4 * i + 1] * rstd * gp.y);
      x[4 * i + 2] += gt.z * (fv[4 * i + 2] * rstd * gp.z);
      x[4 * i + 3] += gt.w * (fv[4 * i + 3] * rstd * gp.w);
    }
  }
  if (outx) {
#pragma unroll
    for (int i = 0; i < 4; ++i) {
      float4 v; v.x = x[4 * i]; v.y = x[4 * i + 1]; v.z = x[4 * i + 2]; v.w = x[4 * i + 3];
      *(float4*)(outx + (i * 64 + lane) * 4) = v;
    }
  }
  if (outh) {
    float ss = 0.f;
#pragma unroll
    for (int i = 0; i < 16; ++i) ss += x[i] * x[i];
    ss = wsum(ss);
    const float rstd = rsqrtf(ss * (1.f / DM) + EPS);
#pragma unroll
    for (int i = 0; i < 4; ++i) {
      const int idx = (i * 64 + lane) * 4;
      const float4 g = *(const float4*)(gpre + idx);
      const float4 s1 = *(const float4*)(sc + idx);
      const float4 s0 = *(const float4*)(sh + idx);
      const float h0 = x[4 * i] * rstd * g.x * (1.f + s1.x) + s0.x;
      const float h1 = x[4 * i + 1] * rstd * g.y * (1.f + s1.y) + s0.y;
      const float h2 = x[4 * i + 2] * rstd * g.z * (1.f + s1.z) + s0.z;
      const float h3 = x[4 * i + 3] * rstd * g.w * (1.f + s1.w) + s0.w;
      uint2 o; o.x = pk2(h0, h1); o.y = pk2(h2, h3);
      *(uint2*)(outh + (size_t)r * DM + idx) = o;
    }
  }
}

DI void phase_rows(const Params& p, int l, int mode) {
  const int tid = tid_l(), lane = tid & 63;
  const int gw = blockIdx.x * 4 + (tid >> 6), nw = gridDim.x * 4;
  const float* mod = (const float*)(p.ws + WS_MOD);
  float* yout = p.out + O_Y;
  for (int r = gw; r < T; r += nw) {
    const int g = grp_of(r);
    const float* ml = mod + (size_t)(l * 5 + g) * 6144;
    if (mode == 0) {
      row_resnorm(r, xin_row(p, r), nullptr, nullptr, nullptr, p.in[11] + l * DM, ml + 1024, ml, nullptr,
                  (u16*)(p.ws + WS_H), lane);
    } else if (mode == 1) {
      const float* xr = (l == 0) ? xin_row(p, r) : yout + (size_t)r * DM;
      row_resnorm(r, xr, (const u16*)(p.ws + WS_MO), p.in[12] + l * DM, ml + 2048, p.in[13] + l * DM, ml + 4096,
                  ml + 3072, yout + (size_t)r * DM, (u16*)(p.ws + WS_H), lane);
    } else {
      const float* mn = mod + (size_t)((l + 1) * 5 + g) * 6144;
      const bool last = (l == DEPTH - 1);
      row_resnorm(r, yout + (size_t)r * DM, (const u16*)(p.ws + WS_M), p.in[14] + l * DM, ml + 5120,
                  last ? nullptr : p.in[11] + (l + 1) * DM, last ? nullptr : mn + 1024, last ? nullptr : mn,
                  yout + (size_t)r * DM, last ? nullptr : (u16*)(p.ws + WS_H), lane);
    }
  }
}

DI void phase_post_proj(const Params& p, int l) {
  const int tid = tid_l(), lane = tid & 63;
  const int gw = blockIdx.x * 4 + (tid >> 6), nw = gridDim.x * 4;
  u16* P = (u16*)(p.ws + WS_P);
  u16* ckvn = (u16*)(p.ws + WS_CKVN);
  u16* xcv = (u16*)(p.ws + WS_XCV);
  const float* gq = p.in[17] + l * 384;
  const float* gkv = p.in[19] + l * 256;
  const float* wc = p.in[22] + l * 4 * 512;
  const float* bc = p.in[23] + l * 512;
  for (int r = gw; r < TC; r += nw) {
    if (r < T) {
      u16* pr = P + (size_t)r * PP;
      {
        float v[6];
        float ss = 0.f;
#pragma unroll
        for (int i = 0; i < 6; ++i) { v[i] = bf2f(pr[C_CQ + i * 64 + lane]); ss += v[i] * v[i]; }
        ss = wsum(ss);
        const float rstd = rsqrtf(ss * (1.f / 384.f) + EPS);
#pragma unroll
        for (int i = 0; i < 6; ++i) pr[C_CQ + i * 64 + lane] = f2bf(v[i] * rstd * gq[i * 64 + lane]);
      }
      {
        float v[4];
        float ss = 0.f;
#pragma unroll
        for (int i = 0; i < 4; ++i) { v[i] = bf2f(pr[C_CKV + i * 64 + lane]); ss += v[i] * v[i]; }
        ss = wsum(ss);
        const float rstd = rsqrtf(ss * (1.f / 256.f) + EPS);
#pragma unroll
        for (int i = 0; i < 4; ++i) {
          const float o = v[i] * rstd * gkv[i * 64 + lane];
          ckvn[(size_t)r * 256 + i * 64 + lane] = f2bf(o);
          if (r < NCTX) {
            const int b = r >> 8, s = r & 255;
            p.out[O_CKV + ((size_t)(b * 4 + l) * 256 + s) * 256 + i * 64 + lane] = o;
          }
        }
      }
      {
        int pos, L;
        if (r < NCTX) { pos = r & 255; L = 256; } else { pos = (r - NCTX) & 4095; L = 4096; }
        float acc[8];
        const float4 b0 = *(const float4*)(bc + lane * 8), b1 = *(const float4*)(bc + lane * 8 + 4);
        acc[0] = b0.x; acc[1] = b0.y; acc[2] = b0.z; acc[3] = b0.w; acc[4] = b1.x; acc[5] = b1.y; acc[6] = b1.z; acc[7] = b1.w;
#pragma unroll
        for (int j = 0; j < 4; ++j) {
          const int pp = pos + j - 1;
          if (pp >= 0 && pp < L) {
            const uint4 u = *(const uint4*)(P + (size_t)(r + j - 1) * PP + C_XC + lane * 8);
            const float4 w0 = *(const float4*)(wc + j * 512 + lane * 8), w1 = *(const float4*)(wc + j * 512 + lane * 8 + 4);
            acc[0] += w0.x * lo_bf(u.x); acc[1] += w0.y * hi_bf(u.x); acc[2] += w0.z * lo_bf(u.y); acc[3] += w0.w * hi_bf(u.y);
            acc[4] += w1.x * lo_bf(u.z); acc[5] += w1.y * hi_bf(u.z); acc[6] += w1.z * lo_bf(u.w); acc[7] += w1.w * hi_bf(u.w);
          }
        }
        uint4 o; o.x = pk2(acc[0], acc[1]); o.y = pk2(acc[2], acc[3]); o.z = pk2(acc[4], acc[5]); o.w = pk2(acc[6], acc[7]);
        *(uint4*)(xcv + (size_t)r * 512 + lane * 8) = o;
      }
    } else {
      const int cr = r - T, b = cr >> 9, pp = cr & 511;
      const float* src = p.in[4] + ((size_t)(b * 4 + l) * 512 + pp) * 256;
#pragma unroll
      for (int i = 0; i < 4; ++i) ckvn[(size_t)r * 256 + i * 64 + lane] = f2bf(src[i * 64 + lane]);
    }
  }
}

template <int HALF>
DI void rope4(float& v0, float& v1, float& v2, float& v3, int cc  , int t0, const float2* tab) {
  const float p0 = __shfl_xor(v0, HALF, 64), p1 = __shfl_xor(v1, HALF, 64), p2 = __shfl_xor(v2, HALF, 64), p3 = __shfl_xor(v3, HALF, 64);
  const int blk = (cc / (2 * HALF)) & 1;
  const int jj = cc % (2 * HALF), j = jj % HALF;
  const float sgn = jj < HALF ? -1.f : 1.f;
  const float inv = __builtin_amdgcn_exp2f(-(float)j * (13.287712379549449f / (float)HALF));
  float vv[4] = {v0, v1, v2, v3}, pp[4] = {p0, p1, p2, p3};
#pragma unroll
  for (int e = 0; e < 4; ++e) {
    const int t = t0 + e;
    const int pos = blk ? (t & 63) : (t >> 6);
    const float rev = ((float)pos * inv) * 0.15915494309189535f;
    vv[e] = vv[e] * __builtin_amdgcn_cosf(rev) + sgn * pp[e] * __builtin_amdgcn_sinf(rev);
  }
  v0 = vv[0]; v1 = vv[1]; v2 = vv[2]; v3 = vv[3];
}

template <int NKS>
struct AttnState {
  bf16x8 bq[NKS];
  f32x16 o0, o1;
  float m, lsum;
};

template <int NKS>
DI void attn_init(AttnState<NKS>& st, const u16* qptr  , int has_sink, float sink_l2e) {
  const int h = (tid_l() & 63) >> 5;
#pragma unroll
  for (int ks = 0; ks < NKS; ++ks) st.bq[ks] = *(const bf16x8*)(qptr + ks * 16 + h * 8);
#pragma unroll
  for (int e = 0; e < 16; ++e) { st.o0[e] = 0.f; st.o1[e] = 0.f; }
  st.m = has_sink ? sink_l2e : -1e30f;
  st.lsum = 0.f;
}

template <int NKS, bool MASKED>
DI void attn_core(AttnState<NKS>& st, const bf16x8 (&ak)[NKS], uint2 v00l, uint2 v00h, uint2 v01l, uint2 v01h, uint2 v10l,
                  uint2 v10h, uint2 v11l, uint2 v11h, float scale_l2e, int qpos, int k0, int h) {
  f32x16 s;
#pragma unroll
  for (int e = 0; e < 16; ++e) s[e] = 0.f;
#pragma unroll
  for (int ks = 0; ks < NKS; ++ks) s = MFMA32(ak[ks], st.bq[ks], s);
  float bm = -3e38f;
#pragma unroll
  for (int e = 0; e < 16; ++e) {
    if (MASKED) {
      const int kpos = k0 + (e & 3) + 8 * (e >> 2) + 4 * h;
      const int d = qpos - kpos;
      if (d > 128 || d < -128) s[e] = -1e30f;
    }
    bm = fmaxf(bm, s[e]);
  }
  bm = fmaxf(bm, __shfl_xor(bm, 32, 64));
  const float mn = fmaxf(st.m, bm * scale_l2e);
  if (__any(mn > st.m + 8.f)) {
    const float alpha = __builtin_amdgcn_exp2f(st.m - mn);
    st.m = mn;
    st.lsum *= alpha;
#pragma unroll
    for (int e = 0; e < 16; ++e) { st.o0[e] *= alpha; st.o1[e] *= alpha; }
  }
  const float mref = st.m;
  float ps = 0.f;
#pragma unroll
  for (int e = 0; e < 16; ++e) { s[e] = __builtin_amdgcn_exp2f(__builtin_fmaf(s[e], scale_l2e, -mref)); ps += s[e]; }
  st.lsum += ps;
  uint4 pq0, pq1;
  pq0.x = pk2(s[0], s[1]); pq0.y = pk2(s[2], s[3]); pq0.z = pk2(s[4], s[5]); pq0.w = pk2(s[6], s[7]);
  pq1.x = pk2(s[8], s[9]); pq1.y = pk2(s[10], s[11]); pq1.z = pk2(s[12], s[13]); pq1.w = pk2(s[14], s[15]);
  const bf16x8 pb0 = __builtin_bit_cast(bf16x8, pq0), pb1 = __builtin_bit_cast(bf16x8, pq1);
  uint4 a;
  a.x = v00l.x; a.y = v00l.y; a.z = v00h.x; a.w = v00h.y;
  st.o0 = MFMA32(__builtin_bit_cast(bf16x8, a), pb0, st.o0);
  a.x = v01l.x; a.y = v01l.y; a.z = v01h.x; a.w = v01h.y;
  st.o0 = MFMA32(__builtin_bit_cast(bf16x8, a), pb1, st.o0);
  a.x = v10l.x; a.y = v10l.y; a.z = v10h.x; a.w = v10h.y;
  st.o1 = MFMA32(__builtin_bit_cast(bf16x8, a), pb0, st.o1);
  a.x = v11l.x; a.y = v11l.y; a.z = v11h.x; a.w = v11h.y;
  st.o1 = MFMA32(__builtin_bit_cast(bf16x8, a), pb1, st.o1);
}

template <int NKS, bool MASKED>
DI void attn_seg(AttnState<NKS>& st, const u16* __restrict__ K, int kst, const u16* __restrict__ Kr, int krst,
                 const u16* __restrict__ Vt, int vst, int kbeg, int kend, float scale_l2e, int qpos) {
  const int lane = tid_l() & 63, r = lane & 31, h = lane >> 5;
  for (int k0 = kbeg; k0 < kend; k0 += 32) {
    const u16* kp = K + (size_t)(k0 + r) * kst + h * 8;
    bf16x8 ak[NKS];
#pragma unroll
    for (int ks = 0; ks < 4; ++ks) ak[ks] = *(const bf16x8*)(kp + ks * 16);
    if (NKS == 6) {
      const u16* krp = Kr + (size_t)(k0 + r) * krst + h * 8;
      ak[NKS - 2] = *(const bf16x8*)(krp);
      ak[NKS - 1] = *(const bf16x8*)(krp + 16);
    }
    const u16* vp = Vt + (size_t)r * vst + k0 + 4 * h;
    const u16* vp1 = vp + (size_t)32 * vst;
    const uint2 v00l = *(const uint2*)(vp), v00h = *(const uint2*)(vp + 8);
    const uint2 v01l = *(const uint2*)(vp + 16), v01h = *(const uint2*)(vp + 24);
    const uint2 v10l = *(const uint2*)(vp1), v10h = *(const uint2*)(vp1 + 8);
    const uint2 v11l = *(const uint2*)(vp1 + 16), v11h = *(const uint2*)(vp1 + 24);
    attn_core<NKS, MASKED>(st, ak, v00l, v00h, v01l, v01h, v10l, v10h, v11l, v11h, scale_l2e, qpos, k0, h);
  }
}

constexpr int MK_P = 104, MV_P = 72;
DI void mla_latent_item(AttnState<6>& st, const u16* kn_lat, const u16* kr_lat, const u16* kn_c, const u16* kr_c,
                        const u16* vt, float scale_l2e, u16* smem) {
  const int tid = tid_l(), lane = tid & 63, r = lane & 31, h = lane >> 5;
  u16* sK = smem;
  u16* sV = smem + 2 * 64 * MK_P;
  const int c0 = tid, c1 = tid + 256;
  const int kr0 = c0 >> 3, kc0 = (c0 & 7) * 8, kr1 = c1 >> 3, kc1 = (c1 & 7) * 8;
  const int rr = tid >> 2, rc = (tid & 3) * 8;
  uint4 g0, g1, g2, g3, g4;
  auto gl = [&](int sidx) {
    const bool lat = sidx < 64;
    const int key0 = lat ? sidx * 64 : (sidx - 64) * 64;
    const u16* kb = (lat ? kn_lat : kn_c) + (size_t)key0 * 512;
    g0 = *(const uint4*)(kb + (size_t)kr0 * 512 + kc0);
    g1 = *(const uint4*)(kb + (size_t)kr1 * 512 + kc1);
    g2 = lat ? *(const uint4*)(kr_lat + (size_t)(key0 + rr) * PP + rc) : *(const uint4*)(kr_c + (size_t)(key0 + rr) * 32 + rc);
    const u16* vb = vt + (lat ? key0 : 4096 + key0);
    g3 = *(const uint4*)(vb + (size_t)kr0 * 4608 + kc0);
    g4 = *(const uint4*)(vb + (size_t)kr1 * 4608 + kc1);
  };
  auto ss = [&](int buf) {
    *(uint4*)(sK + (buf * 64 + kr0) * MK_P + kc0) = g0;
    *(uint4*)(sK + (buf * 64 + kr1) * MK_P + kc1) = g1;
    *(uint4*)(sK + (buf * 64 + rr) * MK_P + 64 + rc) = g2;
    *(uint4*)(sV + (buf * 64 + kr0) * MV_P + kc0) = g3;
    *(uint4*)(sV + (buf * 64 + kr1) * MV_P + kc1) = g4;
  };
  gl(0);
  ss(0);
  __syncthreads();
  const int NST = 72;
  for (int sidx = 0; sidx < NST; ++sidx) {
    const int buf = sidx & 1;
    if (sidx + 1 < NST) gl(sidx + 1);
#pragma unroll
    for (int sub = 0; sub < 2; ++sub) {
      const u16* kp = sK + (buf * 64 + sub * 32 + r) * MK_P + h * 8;
      bf16x8 ak[6];
#pragma unroll
      for (int ks = 0; ks < 6; ++ks) ak[ks] = *(const bf16x8*)(kp + ks * 16);
      const u16* vp = sV + (buf * 64 + r) * MV_P + sub * 32 + 4 * h;
      const u16* vp1 = vp + 32 * MV_P;
      const uint2 v00l = *(const uint2*)(vp), v00h = *(const uint2*)(vp + 8);
      const uint2 v01l = *(const uint2*)(vp + 16), v01h = *(const uint2*)(vp + 24);
      const uint2 v10l = *(const uint2*)(vp1), v10h = *(const uint2*)(vp1 + 8);
      const uint2 v11l = *(const uint2*)(vp1 + 16), v11h = *(const uint2*)(vp1 + 24);
      attn_core<6, false>(st, ak, v00l, v00h, v01l, v01h, v10l, v10h, v11l, v11h, scale_l2e, 0, 0, h);
    }
    if (sidx + 1 < NST) ss(buf ^ 1);
    __syncthreads();
  }
}

constexpr int GK_P = 72, GV_P = 40;
template <bool MASKA>
DI void gqa_staged(AttnState<4>& st, const u16* KA, int kstA, const u16* VA, int vstA, int keyA0, int nA, const u16* KB,
                   int kstB, const u16* VB, int vstB, int nB, float scale_l2e, int qpos, u16* smem) {
  const int tid = tid_l(), lane = tid & 63, r = lane & 31, h = lane >> 5;
  u16* sK = smem;
  u16* sV = smem + 2 * 32 * GK_P;
  const int krow = tid >> 3, kch = (tid & 7) * 8;
  const int vrow = tid >> 2, vch = (tid & 3) * 8;
  const int NST = nA + nB;
  uint4 g0, g1;
  auto gl = [&](int sidx) {
    if (sidx < nA) {
      const int key = keyA0 + sidx * 32;
      g0 = *(const uint4*)(KA + (size_t)(key + krow) * kstA + kch);
      g1 = *(const uint4*)(VA + (size_t)vrow * vstA + key + vch);
    } else {
      const int key = (sidx - nA) * 32;
      g0 = *(const uint4*)(KB + (size_t)(key + krow) * kstB + kch);
      g1 = *(const uint4*)(VB + (size_t)vrow * vstB + key + vch);
    }
  };
  auto ss = [&](int buf) {
    *(uint4*)(sK + (buf * 32 + krow) * GK_P + kch) = g0;
    *(uint4*)(sV + (buf * 64 + vrow) * GV_P + vch) = g1;
  };
  gl(0);
  ss(0);
  __syncthreads();
  for (int sidx = 0; sidx < NST; ++sidx) {
    const int buf = sidx & 1;
    if (sidx + 1 < NST) gl(sidx + 1);
    const u16* kp = sK + (buf * 32 + r) * GK_P + h * 8;
    bf16x8 ak[4];
#pragma unroll
    for (int ks = 0; ks < 4; ++ks) ak[ks] = *(const bf16x8*)(kp + ks * 16);
    const u16* vp = sV + (buf * 64 + r) * GV_P + 4 * h;
    const u16* vp1 = vp + 32 * GV_P;
    const uint2 v00l = *(const uint2*)(vp), v00h = *(const uint2*)(vp + 8);
    const uint2 v01l = *(const uint2*)(vp + 16), v01h = *(const uint2*)(vp + 24);
    const uint2 v10l = *(const uint2*)(vp1), v10h = *(const uint2*)(vp1 + 8);
    const uint2 v11l = *(const uint2*)(vp1 + 16), v11h = *(const uint2*)(vp1 + 24);
    if (MASKA && sidx < nA)
      attn_core<4, true>(st, ak, v00l, v00h, v01l, v01h, v10l, v10h, v11l, v11h, scale_l2e, qpos, keyA0 + sidx * 32, h);
    else
      attn_core<4, false>(st, ak, v00l, v00h, v01l, v01h, v10l, v10h, v11l, v11h, scale_l2e, 0, 0, h);
    if (sidx + 1 < NST) ss(buf ^ 1);
    __syncthreads();
  }
}

template <int NKS>
DI void attn_finish(AttnState<NKS>& st, int has_sink, float sink_l2e, u16* optr  ) {
  const int h = (threadIdx.x & 63) >> 5;
  float lt = st.lsum + __shfl_xor(st.lsum, 32, 64);
  if (has_sink) lt += __builtin_amdgcn_exp2f(sink_l2e - st.m);
  const float inv = 1.f / lt;
#pragma unroll
  for (int g = 0; g < 4; ++g) {
    uint2 a, b;
    a.x = pk2(st.o0[4 * g] * inv, st.o0[4 * g + 1] * inv); a.y = pk2(st.o0[4 * g + 2] * inv, st.o0[4 * g + 3] * inv);
    b.x = pk2(st.o1[4 * g] * inv, st.o1[4 * g + 1] * inv); b.y = pk2(st.o1[4 * g + 2] * inv, st.o1[4 * g + 3] * inv);
    *(uint2*)(optr + 8 * g + 4 * h) = a;
    *(uint2*)(optr + 32 + 8 * g + 4 * h) = b;
  }
}

struct ScanGeo {
  int rbase, sidx, cg, tc, CLS, NS;
};
DI ScanGeo scan_geo(int it) {
  ScanGeo g;
  if (it < 256) { const int b = it >> 6; g.rbase = NCTX + b * 4096; g.sidx = 16 + b; g.cg = (it >> 3) & 7; g.tc = it & 7; g.CLS = 128; g.NS = 32; }
  else { const int j = it - 256, b = j >> 3; g.rbase = b * 256; g.sidx = b; g.cg = j & 7; g.tc = 0; g.CLS = 64; g.NS = 4; }
  return g;
}
DI void scan_coef(float rr, float ig, float x, float cA, float& a, float& u) {
  a = __expf(cA * rr);
  u = __builtin_sqrtf(fmaxf(1.f - a * a, 0.f)) * ig * x;
}
DI void scan_sum_item(const Params& p, int l, int it) {
  const ScanGeo g = scan_geo(it);
  const int tid = tid_l(), sc = tid >> 6, chl = tid & 63, ch = g.cg * 64 + chl;
  const u16* G = (const u16*)(p.ws + WS_G);
  const u16* xcv = (const u16*)(p.ws + WS_XCV);
  float* SUM = (float*)(p.ws + WS_SUM);
  const float cAf = -8.f * log1pf(__expf(-p.in[24][(l * 2 + 0) * 512 + ch]));
  const float cAb = -8.f * log1pf(__expf(-p.in[24][(l * 2 + 1) * 512 + ch]));
  const int slot = g.tc * 4 + sc;
  const size_t row0 = (size_t)g.rbase + (size_t)slot * g.CLS;
  const u16* gp = G + row0 * 2048 + ch;
  const u16* xp = xcv + row0 * 512 + ch;
  float Pf = 1.f, Hf = 0.f, Pb = 1.f, Hb = 0.f;
#pragma unroll 8
  for (int s = 0; s < g.CLS; ++s) {
    const float raf = bf2f(gp[(size_t)s * 2048]), rif = bf2f(gp[(size_t)s * 2048 + 512]);
    const float rab = bf2f(gp[(size_t)s * 2048 + 1024]), rib = bf2f(gp[(size_t)s * 2048 + 1536]);
    const float x = bf2f(xp[(size_t)s * 512]);
    float a, u;
    scan_coef(raf, rif, x, cAf, a, u);
    Hf = a * Hf + u; Pf *= a;
    scan_coef(rab, rib, x, cAb, a, u);
    Hb += Pb * u; Pb *= a;
  }
  float* so = SUM + ((size_t)(g.sidx * 8 + g.cg) * 32 + slot) * 256 + chl;
  so[0] = Pf; so[64] = Hf; so[128] = Pb; so[192] = Hb;
}
DI void scan_apply_item(const Params& p, int l, int it) {
  const ScanGeo g = scan_geo(it);
  const int tid = tid_l(), sc = tid >> 6, chl = tid & 63, ch = g.cg * 64 + chl;
  const u16* G = (const u16*)(p.ws + WS_G);
  const u16* xcv = (const u16*)(p.ws + WS_XCV);
  const u16* P = (const u16*)(p.ws + WS_P);
  u16* yc = (u16*)(p.ws + WS_YC);
  const float* SUM = (const float*)(p.ws + WS_SUM) + (size_t)(g.sidx * 8 + g.cg) * 32 * 256 + chl;
  const float cAf = -8.f * log1pf(__expf(-p.in[24][(l * 2 + 0) * 512 + ch]));
  const float cAb = -8.f * log1pf(__expf(-p.in[24][(l * 2 + 1) * 512 + ch]));
  const int slot = g.tc * 4 + sc;
  const bool lat = g.sidx >= 16;
  float hf = lat ? p.in[6][((size_t)((g.sidx - 16) * 4 + l) * 2 + 0) * 512 + ch] : 0.f;
  float hb = lat ? p.in[6][((size_t)((g.sidx - 16) * 4 + l) * 2 + 1) * 512 + ch] : 0.f;
  for (int s = 0; s < slot; ++s) hf = SUM[(size_t)s * 256] * hf + SUM[(size_t)s * 256 + 64];
  for (int s = g.NS - 1; s > slot; --s) hb = SUM[(size_t)s * 256 + 128] * hb + SUM[(size_t)s * 256 + 192];
  const size_t row0 = (size_t)g.rbase + (size_t)slot * g.CLS;
  const u16* gp = G + row0 * 2048 + ch;
  const u16* xp = xcv + row0 * 512 + ch;
  u16* yp = yc + row0 * 512 + ch;
  const u16* gcp = P + row0 * PP + C_GC + ch;
#pragma unroll 8
  for (int s = 0; s < g.CLS; ++s) {
    const float raf = bf2f(gp[(size_t)s * 2048]), rif = bf2f(gp[(size_t)s * 2048 + 512]);
    const float x = bf2f(xp[(size_t)s * 512]);
    float a, u;
    scan_coef(raf, rif, x, cAf, a, u);
    hf = a * hf + u;
    yp[(size_t)s * 512] = f2bf(hf);
  }
#pragma unroll 8
  for (int s = g.CLS - 1; s >= 0; --s) {
    const float rab = bf2f(gp[(size_t)s * 2048 + 1024]), rib = bf2f(gp[(size_t)s * 2048 + 1536]);
    const float x = bf2f(xp[(size_t)s * 512]);
    float a, u;
    scan_coef(rab, rib, x, cAb, a, u);
    hb = a * hb + u;
    const float hfv = bf2f(yp[(size_t)s * 512]);
    const float gcv = bf2f(gcp[(size_t)s * PP]);
    const float ge = 0.5f * gcv * (1.f + tanhf(0.7978845608028654f * (gcv + 0.044715f * gcv * gcv * gcv)));
    yp[(size_t)s * 512] = f2bf(ge * (hfv + hb));
  }
  if (!lat) {
    float* st = p.out + O_ST + (size_t)(g.sidx * 4 + l) * 1024;
    if (slot == g.NS - 1) st[ch] = hf;
    if (slot == 0) st[512 + ch] = hb;
  }
}

#define XB_TMO      128
#define XB_XCNT(j)  (256  + 64 * (j))
#define XB_XSUB(j)  (1280 + 64 * (j))
#define XB_XGEN(j)  (2304 + 64 * (j))
#define XB_TOP      3328
#define XB_TOPGEN   3392
#define XCD_BAR_WORDS 3456
#define XB_SPIN_CAP (1u << 18)
#define LAS __attribute__((address_space(3)))

__device__ __forceinline__ unsigned xb_ld(unsigned* p)              { return __hip_atomic_load(p, __ATOMIC_RELAXED, __HIP_MEMORY_SCOPE_AGENT); }
__device__ __forceinline__ unsigned xb_add(unsigned* p, unsigned v) { return __hip_atomic_fetch_add(p, v, __ATOMIC_RELAXED, __HIP_MEMORY_SCOPE_AGENT); }
__device__ __forceinline__ unsigned xb_xcc_id() { return (unsigned)__builtin_amdgcn_s_getreg((3 << 11) | 20) & 0xFu; }
#define XB_SPIN(cond, bar) do { unsigned _sp = 0; while (cond) { __builtin_amdgcn_s_sleep(1); \
    if ((++_sp & 255u) == 0u) { if (xb_ld(&(bar)[XB_TMO])) break; if (_sp > XB_SPIN_CAP) { atomicAdd(&(bar)[XB_TMO], 1u); break; } } } } while (0)

struct XcdBarrier {
    unsigned* bar; unsigned x;
    volatile LAS unsigned* st;
};

__device__ __forceinline__ XcdBarrier xcd_barrier_post(unsigned* bar, volatile LAS unsigned* st) {
    XcdBarrier b; b.bar = bar; b.x = xb_xcc_id(); b.st = st;
    if (threadIdx.x == 0) (void)xb_add(&bar[XB_XCNT(b.x)], 1u);
    return b;
}
__device__ __forceinline__ void xcd_barrier_complete(unsigned* bar, unsigned x, unsigned& nloc, unsigned& nx) {
    const unsigned G = gridDim.x * gridDim.y * gridDim.z;
    unsigned sum, cnt, mine, sp = 0u;
    for (;;) {
        sum = 0u; cnt = 0u; mine = 0u;
#pragma unroll
        for (unsigned j = 0; j < 16; ++j) { const unsigned c = xb_ld(&bar[XB_XCNT(j)]); sum += c; cnt += (c > 0u) ? 1u : 0u; mine = (j == x) ? c : mine; }
        if (sum == G) break;
        __builtin_amdgcn_s_sleep(1);
        if ((++sp & 255u) == 0u) { if (xb_ld(&bar[XB_TMO])) break; if (sp > XB_SPIN_CAP) { atomicAdd(&bar[XB_TMO], 1u); break; } }
    }
    nloc = mine > 0u ? mine : 1u; nx = cnt > 0u ? cnt : 1u;
}

__device__ __forceinline__ void xcd_barrier(const XcdBarrier& b) {
    asm volatile("s_waitcnt vmcnt(0)" ::: "memory");
    __syncthreads();
    if (threadIdx.x == 0) {
        unsigned* bar = b.bar;
        __builtin_amdgcn_s_waitcnt(0);
        unsigned nloc = b.st[0], nx = b.st[1];
        if (nloc == 0u) { xcd_barrier_complete(bar, b.x, nloc, nx); b.st[0] = nloc; b.st[1] = nx; }
        const unsigned old = xb_add(&bar[XB_XSUB(b.x)], 1u);
        const unsigned gen = old / nloc;
        if (old + 1u == (gen + 1u) * nloc) {
            __builtin_amdgcn_fence(__ATOMIC_RELEASE, "agent");
            asm volatile("s_waitcnt vmcnt(0)" ::: "memory");
            const unsigned og = xb_add(&bar[XB_TOP], 1u);
            const unsigned tg = og / nx;
            if (og + 1u == (tg + 1u) * nx) xb_add(&bar[XB_TOPGEN], 1u);
            else XB_SPIN(xb_ld(&bar[XB_TOPGEN]) == tg, bar);
            __builtin_amdgcn_fence(__ATOMIC_ACQUIRE, "agent");
            xb_add(&bar[XB_XGEN(b.x)], 1u);
            asm volatile("s_waitcnt vmcnt(0)" ::: "memory");
        } else {
            XB_SPIN(xb_ld(&bar[XB_XGEN(b.x)]) == gen, bar);
            __builtin_amdgcn_fence(__ATOMIC_ACQUIRE, "agent");
            asm volatile("s_waitcnt vmcnt(0)" ::: "memory");
        }
    }
    __syncthreads();
}


#ifndef DBG_STOP
#define DBG_STOP 0
#define DBG_L 0
#endif
DI void dbg_dump(const Params& p, const u16* buf, size_t pitch, int ncols, int nrows, float mul, bool accumulate) {
  const size_t n = (size_t)T * 1024;
  for (size_t i = (size_t)blockIdx.x * 256 + threadIdx.x; i < n; i += (size_t)gridDim.x * 256) {
    const int r = (int)(i >> 10), c = (int)(i & 1023);
    float v = 0.f;
    if (r < nrows)
      for (int cc = c; cc < ncols; cc += 1024) v += bf2f(buf[(size_t)r * pitch + cc]);
    v *= mul;
    if (accumulate) v += p.out[O_Y + i];
    p.out[O_Y + i] = v;
  }
}
DI unsigned dbg_fold(const u16* buf, size_t pitch, int ncols, int r, int c5) {
  unsigned x = 0;
  if (buf)
    for (int cc = c5; cc < ncols; cc += 512) x ^= buf[(size_t)r * pitch + cc];
  return x;
}
DI void dbg_xor(const Params& p, const u16* b0, size_t p0, int n0, const u16* b1 = nullptr, size_t p1 = 0, int n1 = 0,
                const u16* b2 = nullptr, size_t p2 = 0, int n2 = 0, const u16* b3 = nullptr, size_t p3 = 0, int n3 = 0) {
  const size_t n = (size_t)T * 1024;
  for (size_t i = (size_t)blockIdx.x * 256 + threadIdx.x; i < n; i += (size_t)gridDim.x * 256) {
    const int r = (int)(i >> 10), c = (int)(i & 1023), c5 = c & 511;
    unsigned x = dbg_fold(b0, p0, n0, r, c5) ^ dbg_fold(b1, p1, n1, r, c5) ^ dbg_fold(b2, p2, n2, r, c5) ^ dbg_fold(b3, p3, n3, r, c5);
    p.out[O_Y + i] = (float)(c < 512 ? (x & 0xffu) : (x >> 8));
  }
}
#define DBG_AT(n, ...) do { if (DBG_STOP == (n) && l == DBG_L) { __VA_ARGS__; return; } } while (0)

__global__ void __launch_bounds__(256, 2) fwd_megakernel(Params p) {
  cg::grid_group grid = cg::this_grid();
  __shared__ __attribute__((aligned(16))) u16 smem[SMEM_BYTES / 2];
  __shared__ int s_item;
  __shared__ uint4 xb_words;
  if (threadIdx.x == 0) xb_words = make_uint4(0u, 0u, 0u, 0u);
  __syncthreads();
  XcdBarrier xb = xcd_barrier_post((unsigned*)(p.ws + WS_BAR), (volatile LAS unsigned*)&xb_words);
  if (p.ws == nullptr) grid.sync();
  const int tid = threadIdx.x, lane = tid & 63, wave = tid >> 6;
  const int NB = gridDim.x;
  char* ws = p.ws;
  float* mod = (float*)(ws + WS_MOD);
  const float2* tab16 = (const float2*)(ws + WS_TAB16);
  const float2* tab8 = (const float2*)(ws + WS_TAB8);
  u16* wt = (u16*)(ws + WS_WT);
  u16* Hb = (u16*)(ws + WS_H);
  u16* P = (u16*)(ws + WS_P);
  u16* Gt = (u16*)(ws + WS_G);
  u16* ckvn = (u16*)(ws + WS_CKVN);
  u16* xcv = (u16*)(ws + WS_XCV);
  u16* qb = (u16*)(ws + WS_QB);
  u16* kn = (u16*)(ws + WS_KN);
  u16* vml = (u16*)(ws + WS_VML);
  u16* vmc = (u16*)(ws + WS_VMC);
  u16* vgl = (u16*)(ws + WS_VGL);
  u16* vgc = (u16*)(ws + WS_VGC);
  u16* ck = (u16*)(ws + WS_CK);
  u16* ckr = (u16*)(ws + WS_CKR);
  int* ctr = (int*)(ws + WS_CTR);

  if (PHASE_MASK & 1)
  {
    float* ssil = (float*)smem;
    float* sred = ssil + 5 * 1024;
    for (int i = tid; i < 5 * 1024; i += 256) {
      const int g = i >> 10, k = i & 1023;
      const float cv = g == 0 ? p.in[8][k] : p.in[7][(g - 1) * 1024 + k];
      ssil[i] = cv / (1.f + __expf(-cv));
    }
    __syncthreads();
    for (int it = blockIdx.x; it < 4 * 96; it += NB) {
      const int l = it / 96, cc = it % 96;
      const int col = cc * 64 + lane;
      const float* w = p.in[9] + ((size_t)l * 1024 + wave * 256) * 6144 + col;
      const float* sv = ssil + wave * 256;
      float a0 = 0.f, a1 = 0.f, a2 = 0.f, a3 = 0.f, a4 = 0.f;
#pragma unroll 16
      for (int kk = 0; kk < 256; ++kk) {
        const float wv = __builtin_nontemporal_load(w + (size_t)kk * 6144);
        a0 += sv[kk] * wv; a1 += sv[1024 + kk] * wv; a2 += sv[2048 + kk] * wv; a3 += sv[3072 + kk] * wv; a4 += sv[4096 + kk] * wv;
      }
      sred[(wave * 5 + 0) * 64 + lane] = a0; sred[(wave * 5 + 1) * 64 + lane] = a1; sred[(wave * 5 + 2) * 64 + lane] = a2;
      sred[(wave * 5 + 3) * 64 + lane] = a3; sred[(wave * 5 + 4) * 64 + lane] = a4;
      __syncthreads();
      for (int i = tid; i < 320; i += 256) {
        const int g = i >> 6, cl = i & 63;
        const float v = p.in[10][l * 6144 + cc * 64 + cl] + sred[(0 * 5 + g) * 64 + cl] + sred[(1 * 5 + g) * 64 + cl] +
                        sred[(2 * 5 + g) * 64 + cl] + sred[(3 * 5 + g) * 64 + cl];
        mod[(size_t)(l * 5 + g) * 6144 + cc * 64 + cl] = v;
      }
      __syncthreads();
    }
    __syncthreads();
    const int gt = blockIdx.x * 256 + tid, ngt = NB * 256;
    for (int i = gt; i < 16 * 512 * 128 / 2; i += ngt) {
      const float2 v = *(const float2*)(p.in[2] + (size_t)i * 2);
      ((unsigned*)ck)[i] = pk2(v.x, v.y);
    }
    for (int i = gt; i < 16 * 512 * 32 / 2; i += ngt) {
      const float2 v = *(const float2*)(p.in[5] + (size_t)i * 2);
      ((unsigned*)ckr)[i] = pk2(v.x, v.y);
    }
    {
      float* sT = (float*)smem;
      u16* vct = (u16*)(ws + WS_VCT);
      for (int it = blockIdx.x; it < 16 * 2 * 8; it += NB) {
        const int pc = it & 7, kvh = (it >> 3) & 1, bl = it >> 4;
        __syncthreads();
        for (int i = tid; i < 64 * 64; i += 256) {
          const int pp = i >> 6, d = i & 63;
          sT[d * 65 + pp] = p.in[3][((size_t)bl * 512 + pc * 64 + pp) * 128 + kvh * 64 + d];
        }
        __syncthreads();
        for (int i = tid; i < 64 * 32; i += 256) {
          const int d = i >> 5, p2 = (i & 31) * 2;
          *(unsigned*)(vct + ((size_t)(bl * 2 + kvh) * 64 + d) * 512 + pc * 64 + p2) = pk2(sT[d * 65 + p2], sT[d * 65 + p2 + 1]);
        }
      }
      __syncthreads();
    }
    transpose_layer(p, 0, (float*)smem);
  }
  GSYNC();
  phase_rows(p, 0, 0);
  GSYNC();

#pragma unroll 1
  for (int l = 0; l < DEPTH; ++l) {
    DBG_AT(1, dbg_xor(p, Hb, 1024, 1024));
  if (PHASE_MASK & 2)
    {
      const int NT = 20;
      GCarry carry;
      carry.xa0 = carry.xa1 = carry.xa2 = carry.xa3 = carry.xb0 = carry.xb1 = carry.xb2 = carry.xb3 = carry.ya0 = carry.ya1 = carry.ya2 = carry.ya3 = carry.yb0 = carry.yb1 = carry.yb2 = carry.yb3 = make_uint4(0u, 0u, 0u, 0u);
      for (int rep = 0; rep < REP_GEMM; ++rep)
      for (int t = blockIdx.x; t < 160 * NT; t += NB) {
        const int mt = (t & 7) + 8 * ((t >> 3) / NT), nt = (t >> 3) % NT;
        const int m0 = mt * 128, n0 = nt * 128;
        f32x16 acc[2][2];
        zero_acc<2>(acc);
        const int nvalid = (PW - n0) < 128 ? (PW - n0) : 128;
        {
          const int tn_ = t + NB < 160 * NT ? t + NB : t;
          const int mtn = (tn_ & 7) + 8 * ((tn_ >> 3) / NT), ntn = (tn_ >> 3) % NT;
          const int nvn = (PW - ntn * 128) < 128 ? (PW - ntn * 128) : 128;
          gemm_stream(t == (int)blockIdx.x, carry, Hb + (size_t)m0 * 1024, 1024, wt + WT_IN + (size_t)n0 * 1024, 1024, nvalid,
                      Hb + (size_t)mtn * 128 * 1024, wt + WT_IN + (size_t)ntn * 128 * 1024, nvn, 1024, smem, acc);
        }
        const bool isctx = m0 < NCTX;
        gemm_epilogue<2>(acc, [&](int rr, int cc, float v0, float v1, float v2, float v3) {
          const int col = n0 + cc;
          const int ctile = n0 + (cc & ~31);
          if (ctile >= PW) return;
          const int row = m0 + rr;
          if (!isctx) {
            const int t0 = (row - NCTX) & 4095;
            if (!DBG_NOROPE) { if (ctile < C_VA) rope4<16>(v0, v1, v2, v3, col & 63, t0, tab16);
            else if (ctile == C_KR) rope4<8>(v0, v1, v2, v3, col - C_KR, t0, tab8); }
          }
          if (ctile >= C_VA && ctile < C_CQ) {
            const int c = col - C_VA, kvh = c >> 6, d = c & 63;
            uint2 o; o.x = pk2(v0, v1); o.y = pk2(v2, v3);
            if (isctx) {
              const int b = row >> 8, s = row & 255;
              *(uint2*)(vgc + ((size_t)(b * 2 + kvh) * 64 + d) * 256 + s) = o;
              float* ov = p.out + O_V + ((size_t)(b * 4 + l) * 256 + s) * 128 + c;
              ov[0] = v0; ov[128] = v1; ov[256] = v2; ov[384] = v3;
            } else {
              const int b = (row - NCTX) >> 12, tt = (row - NCTX) & 4095;
              *(uint2*)(vgl + ((size_t)(b * 2 + kvh) * 64 + d) * 4608 + tt) = o;
            }
          } else {
            u16* dst = P + (size_t)row * PP + col;
            dst[0] = f2bf(v0); dst[PP] = f2bf(v1); dst[2 * PP] = f2bf(v2); dst[3 * PP] = f2bf(v3);
            if (isctx) {
              const int b = row >> 8, s = row & 255;
              if (ctile >= C_KA && ctile < C_VA) {
                float* ok = p.out + O_K + ((size_t)(b * 4 + l) * 256 + s) * 128 + (col - C_KA);
                ok[0] = v0; ok[128] = v1; ok[256] = v2; ok[384] = v3;
              } else if (ctile == C_KR) {
                float* okr = p.out + O_KR + ((size_t)(b * 4 + l) * 256 + s) * 32 + (col - C_KR);
                okr[0] = v0; okr[32] = v1; okr[64] = v2; okr[96] = v3;
              }
            }
          }
        });
      }
    }
    GSYNC();
    DBG_AT(2, dbg_xor(p, P, PP, 640, P + 768, PP, 1696));
  if (PHASE_MASK & 4)
    phase_post_proj(p, l);
    GSYNC();
    DBG_AT(3, dbg_xor(p, P, PP, PW, ckvn, 256, 256, xcv, 512, 512));
  if (PHASE_MASK & 8)
    {
      const int NQ = 160 * 6, NKV = 176 * 8, NG = 160 * 16;
      for (int rep = 0; rep < REP_GEMM; ++rep)
      for (int t = blockIdx.x; t < NQ + NKV + NG; t += NB) {
        f32x16 acc[2][2];
        zero_acc<2>(acc);
        if (t < NQ) {
          const int mt = (t & 7) + 8 * ((t >> 3) / 6), nt = (t >> 3) % 6, m0 = mt * 128, n0 = nt * 128;
          gemm_mainloop<2>(P + (size_t)m0 * PP + C_CQ, PP, wt + WT_QUP + (size_t)n0 * 384, 384, 128, 384, smem, acc);
          const bool isctx = m0 < NCTX;
          gemm_epilogue<2>(acc, [&](int rr, int cc, float v0, float v1, float v2, float v3) {
            const int col = n0 + cc, row = m0 + rr;
            const int ctile = n0 + (cc & ~31);
            if (!isctx && (ctile % 96) == 64) rope4<8>(v0, v1, v2, v3, (col % 96) - 64, (row - NCTX) & 4095, tab8);
            u16* dst = qb + (size_t)row * 768 + col;
            dst[0] = f2bf(v0); dst[768] = f2bf(v1); dst[2 * 768] = f2bf(v2); dst[3 * 768] = f2bf(v3);
          });
        } else if (t < NQ + NKV) {
          const int tt = t - NQ, mt = (tt & 7) + 8 * (tt >> 6), nt = (tt >> 3) & 7, m0 = mt * 128, n0 = nt * 128;
          gemm_mainloop<2>(ckvn + (size_t)m0 * 256, 256, wt + WT_KV + (size_t)n0 * 256, 256, 128, 256, smem, acc);
          gemm_epilogue<2>(acc, [&](int rr, int cc, float v0, float v1, float v2, float v3) {
            const int col = n0 + cc, row = m0 + rr;
            if (n0 < 512) {
              u16* dst = kn + (size_t)row * 512 + col;
              dst[0] = f2bf(v0); dst[512] = f2bf(v1); dst[1024] = f2bf(v2); dst[1536] = f2bf(v3);
            } else {
              const int c = col - 512, hh = c >> 6, d = c & 63;
              uint2 o; o.x = pk2(v0, v1); o.y = pk2(v2, v3);
              if (row < NCTX) {
                const int b = row >> 8, s = row & 255;
                *(uint2*)(vmc + ((size_t)(b * 8 + hh) * 64 + d) * 256 + s) = o;
              } else if (row < T) {
                const int b = (row - NCTX) >> 12, tk = (row - NCTX) & 4095;
                *(uint2*)(vml + ((size_t)(b * 8 + hh) * 64 + d) * 4608 + tk) = o;
              } else {
                const int b = (row - T) >> 9, pp = (row - T) & 511;
                *(uint2*)(vml + ((size_t)(b * 8 + hh) * 64 + d) * 4608 + 4096 + pp) = o;
              }
            }
          });
        } else {
          const int tt = t - NQ - NKV, mt = (tt & 7) + 8 * (tt >> 7), nb = (tt >> 4) & 7, nt = (tt >> 3) & 1, m0 = mt * 128, n0 = nt * 128;
          gemm_mainloop<2>(xcv + (size_t)m0 * 512 + nb * 64, 512, wt + WT_G + (size_t)(nb * 256 + n0) * 64, 64, 128, 64, smem, acc);
          gemm_epilogue<2>(acc, [&](int rr, int cc, float v0, float v1, float v2, float v3) {
            const int c256 = n0 + cc, which = c256 >> 6, d = c256 & 63, ch = nb * 64 + d, row = m0 + rr;
            const int dir = which >> 1;
            const float bias = ((which & 1) ? p.in[28] : p.in[26])[(l * 2 + dir) * 512 + ch];
            u16* dst = Gt + (size_t)row * 2048 + which * 512 + ch;
            dst[0] = f2bf(sigmoidf_(v0 + bias)); dst[2048] = f2bf(sigmoidf_(v1 + bias));
            dst[4096] = f2bf(sigmoidf_(v2 + bias)); dst[6144] = f2bf(sigmoidf_(v3 + bias));
          });
        }
      }
    }
    GSYNC();
    DBG_AT(4, dbg_xor(p, qb, 768, 768, kn, 512, 512, Gt, 2048, 2048, vml, 1024, 1024));
  if (PHASE_MASK & 16)
    {
      const int r = tid_l() & 31;
      const int NITEMS = 384 + 1024 + 256 + 256;
      for (;;) {
        if (tid == 0) s_item = atomicAdd(&ctr[l * 64], 1);
        __syncthreads();
        const int it = s_item;
        __syncthreads();
        if (it >= NITEMS) break;
        if (it < 384) {
          scan_sum_item(p, l, it);
        } else if (it < 1408) {
          const int idx = it - 384, qt = idx & 127, kvh = (idx >> 7) & 1, b = idx >> 8;
          const int q0 = qt * 32, hq = kvh * 4 + wave;
          const int rowq = NCTX + b * 4096 + q0 + r;
          const float sc = 0.125f * LOG2E;
          const float sk = p.in[16][l * 8 + hq] * LOG2E;
          AttnState<4> st;
          attn_init<4>(st, P + (size_t)rowq * PP + C_QA + hq * 64, 1, sk);
          {
            const int kbeg = q0 - 128 < 0 ? 0 : q0 - 128, kend = q0 + 160 > 4096 ? 4096 : q0 + 160;
            gqa_staged<true>(st, P + (size_t)(NCTX + b * 4096) * PP + C_KA + kvh * 64, PP,
                             vgl + (size_t)(b * 2 + kvh) * 64 * 4608, 4608, kbeg, (kend - kbeg) >> 5,
                             ck + (size_t)(b * 4 + l) * 512 * 128 + kvh * 64, 128,
                             (const u16*)(ws + WS_VCT) + (size_t)((b * 4 + l) * 2 + kvh) * 64 * 512, 512, 16, sc, q0 + r, smem);
          }
          attn_finish<4>(st, 1, sk, (u16*)(ws + WS_YA) + (size_t)rowq * 512 + hq * 64);
        } else if (it < 1664) {
          const int idx = it - 1408, qblk = idx & 1, hh = (idx >> 1) & 7, b = idx >> 4;
          const int q0 = qblk * 128 + wave * 32;
          const int rowq = b * 256 + q0 + r;
          const float sc = 0.10206207261596577f * LOG2E;
          AttnState<6> st;
          attn_init<6>(st, qb + (size_t)rowq * 768 + hh * 96, 0, 0.f);
          attn_seg<6, false>(st, kn + (size_t)(b * 256) * 512 + hh * 64, 512, P + (size_t)(b * 256) * PP + C_KR, PP,
                             vmc + (size_t)(b * 8 + hh) * 64 * 256, 256, 0, 256, sc, 0);
          attn_finish<6>(st, 0, 0.f, (u16*)(ws + WS_YB) + (size_t)rowq * 512 + hh * 64);
        } else {
          const int idx = it - 1664, qt = idx & 7, kvh = (idx >> 3) & 1, b = idx >> 4;
          const int q0 = qt * 32, hq = kvh * 4 + wave;
          const int rowq = b * 256 + q0 + r;
          const float sc = 0.125f * LOG2E;
          const float sk = p.in[16][l * 8 + hq] * LOG2E;
          AttnState<4> st;
          attn_init<4>(st, P + (size_t)rowq * PP + C_QA + hq * 64, 1, sk);
          gqa_staged<false>(st, P + (size_t)(b * 256) * PP + C_KA + kvh * 64, PP, vgc + (size_t)(b * 2 + kvh) * 64 * 256, 256, 0, 8,
                            nullptr, 0, nullptr, 0, 0, sc, 0, smem);
          attn_finish<4>(st, 1, sk, (u16*)(ws + WS_YA) + (size_t)rowq * 512 + hq * 64);
        }
      }
    }
    GSYNC();
  if (PHASE_MASK & 16)
    {
      const int r = tid_l() & 31;
      const int NITEMS = 384 + 1024;
      bool scans_left = true;
      int steal = 0;
      const int xcc = (int)(xb.x & 7u);
      for (;;) {
        if (tid == 0) {
          int v = -1;
          while (v < 0 && steal < 8) {
            const int q = (xcc + steal) & 7;
            const int j = atomicAdd(&ctr[l * 64 + 40 + q], 1);
            if (j < 128) v = 384 + q * 128 + j; else ++steal;
          }
          if (v < 0 && scans_left) { v = atomicAdd(&ctr[l * 64 + 32], 1); if (v >= 384) { v = -1; scans_left = false; } }
          s_item = v < 0 ? (1 << 30) : v;
        }
        __syncthreads();
        const int it = s_item;
        __syncthreads();
        if (it >= NITEMS) break;
        if (it < 384) {
          scan_apply_item(p, l, it);
        } else {
          const int idx = it - 384, qblk = idx & 31, hh = (idx >> 5) & 7, b = idx >> 8;
          const int q0 = qblk * 128 + wave * 32;
          const int rowq = NCTX + b * 4096 + q0 + r;
          const float sc = 0.10206207261596577f * LOG2E;
          for (int rep = 0; rep < REP_MLA; ++rep) {
          AttnState<6> st;
          attn_init<6>(st, qb + (size_t)rowq * 768 + hh * 96, 0, 0.f);
          mla_latent_item(st, kn + (size_t)(NCTX + b * 4096) * 512 + hh * 64, P + (size_t)(NCTX + b * 4096) * PP + C_KR,
                          kn + (size_t)(T + b * 512) * 512 + hh * 64, ckr + (size_t)(b * 4 + l) * 512 * 32,
                          vml + (size_t)(b * 8 + hh) * 64 * 4608, sc, smem);
          attn_finish<6>(st, 0, 0.f, (u16*)(ws + WS_YB) + (size_t)rowq * 512 + hh * 64);
          }
        }
      }
    }
    GSYNC();
    DBG_AT(5, dbg_xor(p, (const u16*)(ws + WS_YC), 512, 512));
  if (PHASE_MASK & 32)
    {
      u16* Mb = (u16*)(ws + WS_M);
      for (int t = blockIdx.x; t < 160 * 8; t += NB) {
        const int mt = (t & 7) + 8 * (t >> 6), nt = (t >> 3) & 7, m0 = mt * 128, n0 = nt * 128;
        unsigned mpk[2][2][8];
#pragma unroll
        for (int i = 0; i < 2; ++i)
#pragma unroll
          for (int j = 0; j < 2; ++j)
#pragma unroll
            for (int e = 0; e < 8; ++e) mpk[i][j][e] = 0u;
#pragma unroll 1
        for (int n = 0; n < 3; ++n) {
          f32x16 acc[2][2];
          zero_acc<2>(acc);
          gemm_mainloop<2>(Hb + (size_t)m0 * 1024, 1024, wt + WT_IN + (size_t)(C_GL + n * 1024 + n0) * 1024, 1024, 128, 1024, smem, acc);
          gemm_epilogue<2>(acc, [&](int rr, int cc, float v0, float v1, float v2, float v3) {
            u16* dst = Mb + (size_t)(m0 + rr) * 1024 + n0 + cc;
            dst[0] = f2bf(sigmoidf_(v0)); dst[1024] = f2bf(sigmoidf_(v1)); dst[2048] = f2bf(sigmoidf_(v2)); dst[3072] = f2bf(sigmoidf_(v3));
          });
          zero_acc<2>(acc);
          const u16* Y = (const u16*)(ws + WS_YA) + (size_t)n * T * 512;
          gemm_mainloop<2>(Y + (size_t)m0 * 512, 512, wt + WT_BR + (size_t)(n * 1024 + n0) * 512, 512, 128, 512, smem, acc);
          {
            const int tid3 = tid_l(), lane3 = tid3 & 63, wave3 = tid3 >> 6, r3 = lane3 & 31, h3 = lane3 >> 5;
            const int wm3 = wave3 >> 1, wn3 = wave3 & 1;
#pragma unroll
            for (int i = 0; i < 2; ++i)
#pragma unroll
              for (int j = 0; j < 2; ++j)
#pragma unroll
                for (int g = 0; g < 4; ++g) {
                  const u16* src = Mb + (size_t)(m0 + wm3 * 64 + i * 32 + 8 * g + 4 * h3) * 1024 + n0 + wn3 * 64 + j * 32 + r3;
                  const float g0 = bf2f(src[0]), g1 = bf2f(src[1024]), g2 = bf2f(src[2048]), g3 = bf2f(src[3072]);
                  mpk[i][j][2 * g] = pk2(lo_bf(mpk[i][j][2 * g]) + g0 * acc[i][j][4 * g], hi_bf(mpk[i][j][2 * g]) + g1 * acc[i][j][4 * g + 1]);
                  mpk[i][j][2 * g + 1] = pk2(lo_bf(mpk[i][j][2 * g + 1]) + g2 * acc[i][j][4 * g + 2], hi_bf(mpk[i][j][2 * g + 1]) + g3 * acc[i][j][4 * g + 3]);
                }
          }
        }
        {
          const int tid2 = tid_l(), lane2 = tid2 & 63, wave2 = tid2 >> 6, r2 = lane2 & 31, h2 = lane2 >> 5;
          const int wm2 = wave2 >> 1, wn2 = wave2 & 1;
#pragma unroll
          for (int i = 0; i < 2; ++i)
#pragma unroll
            for (int j = 0; j < 2; ++j)
#pragma unroll
              for (int g = 0; g < 4; ++g) {
                u16* dst = Mb + (size_t)(m0 + wm2 * 64 + i * 32 + 8 * g + 4 * h2) * 1024 + n0 + wn2 * 64 + j * 32 + r2;
                dst[0] = (u16)(mpk[i][j][2 * g] & 0xffffu); dst[1024] = (u16)(mpk[i][j][2 * g] >> 16);
                dst[2048] = (u16)(mpk[i][j][2 * g + 1] & 0xffffu); dst[3072] = (u16)(mpk[i][j][2 * g + 1] >> 16);
              }
        }
      }
    }
    GSYNC();
    DBG_AT(6, dbg_xor(p, (const u16*)(ws + WS_M), 1024, 1024));
  if (PHASE_MASK & 64)
    {
      const u16* Mb = (const u16*)(ws + WS_M);
      u16* Mo = (u16*)(ws + WS_MO);
      GCarry carry;
      carry.xa0 = carry.xa1 = carry.xa2 = carry.xa3 = carry.xb0 = carry.xb1 = carry.xb2 = carry.xb3 = carry.ya0 = carry.ya1 = carry.ya2 = carry.ya3 = carry.yb0 = carry.yb1 = carry.yb2 = carry.yb3 = make_uint4(0u, 0u, 0u, 0u);
      for (int rep = 0; rep < REP_GEMM; ++rep)
      for (int t = blockIdx.x; t < 160 * 8; t += NB) {
        const int mt = (t & 7) + 8 * (t >> 6), nt = (t >> 3) & 7, m0 = mt * 128, n0 = nt * 128;
        f32x16 acc[2][2];
        zero_acc<2>(acc);
        {
          const int tn_ = t + NB < 160 * 8 ? t + NB : t;
          const int mtn = (tn_ & 7) + 8 * (tn_ >> 6), ntn = (tn_ >> 3) & 7;
          gemm_stream(t == (int)blockIdx.x, carry, Mb + (size_t)m0 * 1024, 1024, wt + WT_OUT + (size_t)n0 * 1024, 1024, 128,
                      Mb + (size_t)mtn * 128 * 1024, wt + WT_OUT + (size_t)ntn * 128 * 1024, 128, 1024, smem, acc);
        }
        gemm_epilogue<2>(acc, [&](int rr, int cc, float v0, float v1, float v2, float v3) {
          u16* dst = Mo + (size_t)(m0 + rr) * 1024 + n0 + cc;
          dst[0] = f2bf(v0); dst[1024] = f2bf(v1); dst[2048] = f2bf(v2); dst[3072] = f2bf(v3);
        });
      }
    }
    GSYNC();
    DBG_AT(7, dbg_xor(p, (const u16*)(ws + WS_MO), 1024, 1024));
  if (PHASE_MASK & 128)
    phase_rows(p, l, 1);
    GSYNC();
    DBG_AT(8, dbg_xor(p, Hb, 1024, 1024));
  if (PHASE_MASK & 256)
    {
      u16* F1 = (u16*)(ws + WS_F1);
      GCarry carry;
      carry.xa0 = carry.xa1 = carry.xa2 = carry.xa3 = carry.xb0 = carry.xb1 = carry.xb2 = carry.xb3 = carry.ya0 = carry.ya1 = carry.ya2 = carry.ya3 = carry.yb0 = carry.yb1 = carry.yb2 = carry.yb3 = make_uint4(0u, 0u, 0u, 0u);
      for (int rep = 0; rep < REP_GEMM; ++rep)
      for (int t = blockIdx.x; t < 160 * 32; t += NB) {
        const int mt = (t & 7) + 8 * (t >> 8), nt = (t >> 3) & 31, m0 = mt * 128, n0 = nt * 128;
        f32x16 acc[2][2];
        zero_acc<2>(acc);
        {
          const int tn_ = t + NB < 160 * 32 ? t + NB : t;
          const int mtn = (tn_ & 7) + 8 * (tn_ >> 8), ntn = (tn_ >> 3) & 31;
          gemm_stream(t == (int)blockIdx.x, carry, Hb + (size_t)m0 * 1024, 1024, wt + WT_FF1 + (size_t)n0 * 1024, 1024, 128,
                      Hb + (size_t)mtn * 128 * 1024, wt + WT_FF1 + (size_t)ntn * 128 * 1024, 128, 1024, smem, acc);
        }
        gemm_epilogue<2>(acc, [&](int rr, int cc, float v0, float v1, float v2, float v3) {
          u16* dst = F1 + (size_t)(m0 + rr) * 4096 + n0 + cc;
          v0 = fmaxf(v0, 0.f); v1 = fmaxf(v1, 0.f); v2 = fmaxf(v2, 0.f); v3 = fmaxf(v3, 0.f);
          dst[0] = f2bf(v0 * v0); dst[4096] = f2bf(v1 * v1); dst[8192] = f2bf(v2 * v2); dst[12288] = f2bf(v3 * v3);
        });
      }
    }
    GSYNC();
    DBG_AT(9, dbg_xor(p, (const u16*)(ws + WS_F1), 4096, 4096));
  if (PHASE_MASK & 512)
    {
      const u16* F1 = (const u16*)(ws + WS_F1);
      u16* F2 = (u16*)(ws + WS_M);
      GCarry carry;
      carry.xa0 = carry.xa1 = carry.xa2 = carry.xa3 = carry.xb0 = carry.xb1 = carry.xb2 = carry.xb3 = carry.ya0 = carry.ya1 = carry.ya2 = carry.ya3 = carry.yb0 = carry.yb1 = carry.yb2 = carry.yb3 = make_uint4(0u, 0u, 0u, 0u);
      for (int rep = 0; rep < REP_GEMM; ++rep)
      for (int t = blockIdx.x; t < 160 * 8; t += NB) {
        const int mt = (t & 7) + 8 * (t >> 6), nt = (t >> 3) & 7, m0 = mt * 128, n0 = nt * 128;
        f32x16 acc[2][2];
        zero_acc<2>(acc);
        {
          const int tn_ = t + NB < 160 * 8 ? t + NB : t;
          const int mtn = (tn_ & 7) + 8 * (tn_ >> 6), ntn = (tn_ >> 3) & 7;
          gemm_stream(t == (int)blockIdx.x, carry, F1 + (size_t)m0 * 4096, 4096, wt + WT_FF2 + (size_t)n0 * 4096, 4096, 128,
                      F1 + (size_t)mtn * 128 * 4096, wt + WT_FF2 + (size_t)ntn * 128 * 4096, 128, 4096, smem, acc);
        }
        gemm_epilogue<2>(acc, [&](int rr, int cc, float v0, float v1, float v2, float v3) {
          u16* dst = F2 + (size_t)(m0 + rr) * 1024 + n0 + cc;
          dst[0] = f2bf(v0); dst[1024] = f2bf(v1); dst[2048] = f2bf(v2); dst[3072] = f2bf(v3);
        });
      }
    }
    GSYNC();
    DBG_AT(10, dbg_xor(p, (const u16*)(ws + WS_M), 1024, 1024));
  if (PHASE_MASK & 1024)
    phase_rows(p, l, 2);
    if (l + 1 < DEPTH) {
      transpose_layer(p, l + 1, (float*)smem);
      GSYNC();
    }
  }
}

extern "C" void kernel_launch(void* const* d_in, const int* in_sizes, int n_in, void* d_out, int out_size, void* d_ws,
                              size_t ws_size, hipStream_t stream) {
  if (ws_size < WS_END || n_in < 33) {
    fprintf(stderr, "workspace too small: %zu < %zu\n", ws_size, (size_t)WS_END);
    return;
  }
  static int grid_blocks = 0;
  if (!grid_blocks) {
    int dev = 0, cus = 0, per_cu = 0;
    hipGetDevice(&dev);
    hipDeviceGetAttribute(&cus, hipDeviceAttributeMultiprocessorCount, dev);
    hipOccupancyMaxActiveBlocksPerMultiprocessor(&per_cu, fwd_megakernel, 256, 0);
    if (per_cu > 2) per_cu = 2;
    if (per_cu < 1) per_cu = 1;
    grid_blocks = cus * per_cu;
  }
  Params p{};
  for (int i = 0; i < 33; ++i) p.in[i] = (const float*)d_in[i];
  p.out = (float*)d_out;
  p.ws = (char*)d_ws;
  hipMemsetAsync(d_ws, 0, WS_ZERO_BYTES, stream);
  void* args[] = {&p};
  hipError_t e = hipLaunchCooperativeKernel((void*)fwd_megakernel, dim3(grid_blocks), dim3(256), args, 0, stream);
  if (e != hipSuccess) fprintf(stderr, "cooperative launch failed: %s (grid %d)\n", hipGetErrorString(e), grid_blocks);
}
```
